# Optimizing an MI355X kernel written in HIP

```python
import jax, jax.numpy as jnp
from jax import lax
import numpy as np

D_MODEL = 1024
BATCH = 2
SEQ = 8192
DEPTH = 1

N_HEADS = 8
HEAD_DIM = 64
ATTN_WIDTH = N_HEADS * HEAD_DIM
N_IDX_HEADS = 8
IDX_DIM = 64
TOPK_MAX = 256
Q_BLOCK = 128
CONV_CH = 512
CONV_KERNEL = 31
D_FF = -(-8 * D_MODEL // (3 * 256)) * 256
PLE_DIM = 256
EPS = 1e-6

IN_SIZES = (ATTN_WIDTH, ATTN_WIDTH, ATTN_WIDTH, N_IDX_HEADS * IDX_DIM, IDX_DIM,
            N_IDX_HEADS, 2 * CONV_CH, D_MODEL, D_MODEL)
IN_WIDTH = sum(IN_SIZES)

kernel_name = "hybrid_dsa_conformer_gated_block"


def _split_points():
    pts, acc = [], 0
    for s in IN_SIZES[:-1]:
        acc += s
        pts.append(acc)
    return pts


def rms_norm(x, g):
    xf = x.astype(jnp.float32)
    y = xf * lax.rsqrt(jnp.mean(xf * xf, axis=-1, keepdims=True) + EPS)
    return (y * g.astype(jnp.float32)).astype(x.dtype)


def layer_norm(x, g, b):
    xf = x.astype(jnp.float32)
    mu = jnp.mean(xf, axis=-1, keepdims=True)
    var = jnp.mean(jnp.square(xf - mu), axis=-1, keepdims=True)
    y = (xf - mu) * lax.rsqrt(var + EPS)
    return (y * g.astype(jnp.float32) + b.astype(jnp.float32)).astype(x.dtype)


def dsa_attention(q, k, v, qi, ki, wi, topk):
    B, S, H, D = q.shape
    nb = S // Q_BLOCK
    key_pos = jnp.arange(S)
    q = q * (D ** -0.5)
    wi = wi * (N_IDX_HEADS ** -0.5)

    def block(n):
        t0 = n * Q_BLOCK
        qb = lax.dynamic_slice_in_dim(q, t0, Q_BLOCK, axis=1)
        qib = lax.dynamic_slice_in_dim(qi, t0, Q_BLOCK, axis=1)
        wib = lax.dynamic_slice_in_dim(wi, t0, Q_BLOCK, axis=1)
        qpos = t0 + jnp.arange(Q_BLOCK)
        causal = key_pos[None, :] <= qpos[:, None]
        rel = jax.nn.relu(jnp.einsum('bqhd,bsd->bqhs', qib, ki).astype(jnp.float32)
                          * (IDX_DIM ** -0.5))
        score = jnp.einsum('bqhs,bqh->bqs', rel, wib.astype(jnp.float32))
        score = jnp.where(causal[None], score, -jnp.inf)
        _, idx = lax.top_k(score, topk)
        ksel = jax.vmap(lambda kb, ib: kb[ib])(k, idx)
        vsel = jax.vmap(lambda vb, ib: vb[ib])(v, idx)
        logits = jnp.einsum('bqhd,bqkhd->bqhk', qb, ksel).astype(jnp.float32)
        valid = idx <= qpos[None, :, None]
        logits = jnp.where(valid[:, :, None, :], logits, -jnp.inf)
        probs = jax.nn.softmax(logits, axis=-1).astype(v.dtype)
        return jnp.einsum('bqhk,bqkhd->bqhd', probs, vsel)

    out = lax.map(block, jnp.arange(nb))
    return out.transpose(1, 0, 2, 3, 4).reshape(B, S, H * D)


def conformer_conv(u, conv_w, conv_b, ln_g, ln_b):
    a, g = jnp.split(u, 2, axis=-1)
    glu = a * jax.nn.sigmoid(g)
    y = lax.conv_general_dilated(
        glu, conv_w.astype(glu.dtype), window_strides=(1,),
        padding=[(CONV_KERNEL - 1, 0)],
        dimension_numbers=('NWC', 'WIO', 'NWC'),
        feature_group_count=CONV_CH)
    y = y + conv_b
    y = layer_norm(y, ln_g, ln_b)
    return jax.nn.silu(y)


def setup_inputs(seed: int = 0) -> dict:
    key = jax.random.key(seed)
    ks = jax.random.split(key, 24)
    f32 = jnp.float32

    def nrm(k, shape, fan_in):
        return jax.random.normal(k, shape, f32) * (fan_in ** -0.5)

    def gain(k, shape):
        return 1.0 + 0.01 * jax.random.normal(k, shape, f32)

    L = DEPTH
    return {
        "x": jax.random.normal(ks[0], (BATCH, SEQ, D_MODEL), f32),
        "p": jax.random.normal(ks[1], (DEPTH, BATCH, SEQ, PLE_DIM), f32),
        "g_mix": gain(ks[2], (L, D_MODEL)),
        "w_in": nrm(ks[3], (L, D_MODEL, IN_WIDTH), D_MODEL),
        "g_q": gain(ks[4], (L, HEAD_DIM)),
        "g_k": gain(ks[5], (L, HEAD_DIM)),
        "conv_w": nrm(ks[6], (L, CONV_KERNEL, 1, CONV_CH), CONV_KERNEL),
        "conv_b": 0.01 * jax.random.normal(ks[7], (L, CONV_CH), f32),
        "conv_ln_g": gain(ks[8], (L, CONV_CH)),
        "conv_ln_b": 0.01 * jax.random.normal(ks[9], (L, CONV_CH), f32),
        "w_attn_o": nrm(ks[10], (L, ATTN_WIDTH, D_MODEL), ATTN_WIDTH),
        "w_conv_o": nrm(ks[11], (L, CONV_CH, D_MODEL), CONV_CH),
        "w_out": nrm(ks[12], (L, D_MODEL, D_MODEL), D_MODEL),
        "g_ffn": gain(ks[13], (L, D_MODEL)),
        "w_ffn_gate": nrm(ks[14], (L, D_MODEL, D_FF), D_MODEL),
        "w_ffn_up": nrm(ks[15], (L, D_MODEL, D_FF), D_MODEL),
        "w_ffn_down": nrm(ks[16], (L, D_FF, D_MODEL), D_FF),
        "g_ple": gain(ks[17], (L, D_MODEL)),
        "w_ple_gate": nrm(ks[18], (L, D_MODEL, D_MODEL), D_MODEL),
        "w_ple_proj": nrm(ks[19], (L, PLE_DIM, D_MODEL), PLE_DIM),
    }


def reference(x, p, g_mix, w_in, g_q, g_k, conv_w, conv_b, conv_ln_g, conv_ln_b,
              w_attn_o, w_conv_o, w_out, g_ffn, w_ffn_gate, w_ffn_up, w_ffn_down,
              g_ple, w_ple_gate, w_ple_proj):
    B, S, _ = x.shape
    topk = min(TOPK_MAX, S // 4)
    pts = _split_points()
    for i in range(DEPTH):
        h = rms_norm(x, g_mix[i])
        proj = h @ w_in[i]
        q, k, v, qi, ki, wi, conv_in, gate_a, gate_c = jnp.split(proj, pts, axis=-1)
        q = rms_norm(q.reshape(B, S, N_HEADS, HEAD_DIM), g_q[i])
        k = rms_norm(k.reshape(B, S, N_HEADS, HEAD_DIM), g_k[i])
        v = v.reshape(B, S, N_HEADS, HEAD_DIM)
        qi = qi.reshape(B, S, N_IDX_HEADS, IDX_DIM)
        attn = dsa_attention(q, k, v, qi, ki, wi, topk)
        conv = conformer_conv(conv_in, conv_w[i], conv_b[i],
                              conv_ln_g[i], conv_ln_b[i])
        merged = (jax.nn.sigmoid(gate_a) * (attn @ w_attn_o[i])
                  + jax.nn.sigmoid(gate_c) * (conv @ w_conv_o[i]))
        x = x + merged @ w_out[i]
        hf = rms_norm(x, g_ffn[i])
        x = x + (jax.nn.silu(hf @ w_ffn_gate[i]) * (hf @ w_ffn_up[i])) @ w_ffn_down[i]
        hp = rms_norm(x, g_ple[i])
        x = x + jax.nn.sigmoid(hp @ w_ple_gate[i]) * (p[i] @ w_ple_proj[i])
    return x
```

```cpp
#include <hip/hip_runtime.h>
#include <hip/hip_cooperative_groups.h>
#include <hip/hip_bf16.h>
#include <cmath>
#include <cstdio>
#include <cstdint>
namespace cg = cooperative_groups;
namespace pg8 {
#define PG8_LAS __attribute__((address_space(3)))
typedef unsigned short bf16_t;
typedef _Float16 bf16x8 __attribute__((ext_vector_type(8)));
typedef float f32x4 __attribute__((ext_vector_type(4)));
typedef unsigned u32x4 __attribute__((ext_vector_type(4)));
constexpr int BM = 256, BK = 64, HALF = 128, HTB = HALF * BK * 2  , STAGE_BYTES = 8 * HTB, NXCD = 8, WGM = 8;

__host__ __device__ __forceinline__ int lds_byte(int r, int c) { const int st = (r >> 4) * 2 + (c >> 5), rr = r & 15, cc = c & 31, ob = rr * 64 + cc * 2; return st * 1024 + (ob ^ (((ob >> 9) & 1) << 5)); }
__host__ __device__ __forceinline__ void stage_rc(int b, int& R, int& C) { const int st = b / 1024, sb = b % 1024, swz = sb ^ (((sb >> 9) & 1) << 5); R = (st >> 1) * 16 + swz / 64; C = (st & 1) * 32 + (swz % 64) / 2; }
__host__ __device__ __forceinline__ int perm32(int rho) { const int n = rho >> 4, i = rho & 15; return 8 * (i >> 2) + 4 * n + (i & 3); }

struct Unit { int pm, pn; };
struct Gemm { const bf16_t* A; const bf16_t* Bt; int M, N, K; };

struct StaticOrder {
    int nM, nN, nwg, G, c;
    __host__ __device__ void init(int M, int N, int G_, int c_) { nM = M / BM; nN = N / BM; nwg = nM * nN; G = G_; c = c_; }
    __host__ __device__ bool next(int i, Unit& u) const {
        const long L = (long)i * G + c; if (L >= nwg) return false;
        int wgid = (int)L; { const int q = nwg / NXCD, r = nwg % NXCD, xcd = wgid % NXCD, off = wgid / NXCD; wgid = (xcd < r ? xcd * (q + 1) : r * (q + 1) + (xcd - r) * q) + off; }
        const int nig = WGM * nN, gid = wgid / nig, fm = gid * WGM, gsz = (nM - fm) < WGM ? (nM - fm) : WGM;
        u.pm = fm + ((wgid % nig) % gsz); u.pn = (wgid % nig) / gsz; return true;
    }
    __device__ __forceinline__ void a_ready(const Unit&) const {}
    __device__ __forceinline__ void done(const Unit&) const {}
};

template <class Epi, class Sched, bool ALIGN_EPI = false, bool SP2 = false>
__device__ __forceinline__ void gemm_phase(PG8_LAS unsigned char* lds, const Gemm g, const Sched& S, const Epi& E, const int wid_in) {
    int lane; asm volatile("v_mbcnt_lo_u32_b32 %0, -1, 0\n\tv_mbcnt_hi_u32_b32 %0, -1, %0" : "=v"(lane)); const int wid = wid_in, tid = wid * 64 + lane, wr = wid >> 2, wc = wid & 3, fr = lane & 15, fq = lane >> 4;
    const int K = g.K, nt = K / BK;
    unsigned voffA[2], voffB[2];
#pragma unroll
    for (int i = 0; i < 2; ++i) { int R, C; stage_rc(tid * 16 + i * 8192, R, C); const int Rb = Epi::PERM ? ((R & ~31) + perm32(R & 31)) : R;
        voffA[i] = (unsigned)(R * K + C) * 2u; voffB[i] = (unsigned)(Rb * K + C) * 2u; }
    const size_t kstep = (size_t)(BK * 2);
    const size_t hstep = (size_t)HALF * K * 2;
    const size_t tstep = 2 * hstep;
    const unsigned ldsw = (unsigned)wid * 1024u;
    const int aoff = lds_byte(wr * 64 + fr, fq * 8), boff = lds_byte(wc * 32 + fr, fq * 8);
#define PG8_SA(b, h) (((b) * 2 + (h)) * HTB)
#define PG8_SB(b, h) ((4 + (b) * 2 + (h)) * HTB)
#define PG8_STAGE(bufoff, gbase, voff) do { _Pragma("unroll") for (int _i = 0; _i < 2; ++_i) \
        __builtin_amdgcn_global_load_lds((const unsigned*)((const char*)(gbase) + (voff)[_i]), (PG8_LAS unsigned*)(lds + (bufoff) + ldsw + _i * 8192), 16, 0, 0); } while (0)
#define PG8_LDA(dst, b, h) do { _Pragma("unroll") for (int m = 0; m < 4; ++m) _Pragma("unroll") for (int k = 0; k < 2; ++k) dst[m][k] = *(const PG8_LAS bf16x8*)(lds + PG8_SA(b, h) + aoff + m * 2048 + k * 1024); } while (0)
#define PG8_LDB(dst, b, h) do { _Pragma("unroll") for (int n = 0; n < 2; ++n) _Pragma("unroll") for (int k = 0; k < 2; ++k) dst[n][k] = *(const PG8_LAS bf16x8*)(lds + PG8_SB(b, h) + boff + n * 2048 + k * 1024); } while (0)
#define PG8_MMA(ai, bj, At, Bt) do { __builtin_amdgcn_s_setprio(1); _Pragma("unroll") for (int m = 0; m < 4; ++m) _Pragma("unroll") for (int n = 0; n < 2; ++n) _Pragma("unroll") for (int k = 0; k < 2; ++k) \
        acc[ai][bj][m][n] = __builtin_amdgcn_mfma_f32_16x16x32_f16(Bt[n][k], At[m][k], acc[ai][bj][m][n], 0, 0, 0); __builtin_amdgcn_s_setprio(0); } while (0)
#define PG8_WAIT_V(n) asm volatile("s_waitcnt vmcnt(" #n ")" ::: "memory")
#define PG8_WAIT_L(n) asm volatile("s_waitcnt lgkmcnt(" #n ")" ::: "memory")
#define PG8_BAR __builtin_amdgcn_s_barrier()
#define PG8_SCHED __builtin_amdgcn_sched_barrier(0)
    Unit cur, nxt; int ui = 0;
    if (!S.next(0, cur)) return;
    f32x4 acc[2][2][4][2];
#pragma unroll
    for (int a = 0; a < 2; ++a)
#pragma unroll
        for (int b = 0; b < 2; ++b)
#pragma unroll
            for (int m = 0; m < 4; ++m)
#pragma unroll
                for (int n = 0; n < 2; ++n) acc[a][b][m][n] = (f32x4){0.f, 0.f, 0.f, 0.f};
    bf16x8 At[4][2], B0[2][2], B1[2][2];
    const char* cA = (const char*)g.A + (size_t)cur.pm * tstep; const char* cB = (const char*)g.Bt + (size_t)cur.pn * tstep;
    S.a_ready(cur);
    if constexpr (SP2) {
        PG8_STAGE(PG8_SB(0, 0), cB, voffB); PG8_STAGE(PG8_SB(0, 1), cB + hstep, voffB); PG8_STAGE(PG8_SA(0, 0), cA, voffA); PG8_STAGE(PG8_SA(0, 1), cA + hstep, voffA);
        if (wr == 1) PG8_BAR;
        PG8_WAIT_V(2); PG8_BAR;
        PG8_STAGE(PG8_SB(1, 0), cB + kstep, voffB); PG8_STAGE(PG8_SA(1, 0), cA + kstep, voffA); PG8_STAGE(PG8_SB(1, 1), cB + hstep + kstep, voffB);
        PG8_WAIT_V(6); PG8_BAR;
    } else {
        PG8_STAGE(PG8_SB(0, 0), cB, voffB); PG8_STAGE(PG8_SA(0, 0), cA, voffA); PG8_STAGE(PG8_SB(0, 1), cB + hstep, voffB); PG8_STAGE(PG8_SA(0, 1), cA + hstep, voffA);
        if (wr == 1) PG8_BAR;
        PG8_WAIT_V(4); PG8_BAR;
        PG8_STAGE(PG8_SB(1, 0), cB + kstep, voffB); PG8_STAGE(PG8_SA(1, 0), cA + kstep, voffA); PG8_STAGE(PG8_SB(1, 1), cB + hstep + kstep, voffB);
        PG8_WAIT_V(6); PG8_BAR;
    }
    for (;;) {
        const bool has_next = S.next(ui + 1, nxt);
        const char* nA = has_next ? (const char*)g.A + (size_t)nxt.pm * tstep : cA; const char* nB = has_next ? (const char*)g.Bt + (size_t)nxt.pn * tstep : cB;
        for (int t = 0; t < nt; t += 2) {
            const bool last = (t == nt - 2);
            const char* a1 = cA + (size_t)(t + 1) * kstep;
            const char* a2 = last ? nA : cA + (size_t)(t + 2) * kstep; const char* b2 = last ? nB : cB + (size_t)(t + 2) * kstep;
            const char* a3 = a2 + kstep; const char* b3 = b2 + kstep;
            if (last && has_next) S.a_ready(nxt);
            if constexpr (SP2) {
            PG8_LDB(B0, 0, 0); PG8_LDB(B1, 0, 1); PG8_SCHED; PG8_LDA(At, 0, 0); PG8_STAGE(PG8_SA(1, 1), a1 + hstep, voffA);
            PG8_WAIT_V(8); PG8_WAIT_L(0); PG8_BAR; PG8_MMA(0, 0, At, B0); PG8_MMA(0, 1, At, B1); PG8_BAR; PG8_SCHED;
            PG8_LDA(At, 0, 1); PG8_STAGE(PG8_SB(0, 0), b2, voffB); PG8_STAGE(PG8_SB(0, 1), b2 + hstep, voffB); PG8_STAGE(PG8_SA(0, 0), a2, voffA);
            PG8_WAIT_V(8); PG8_WAIT_L(0); PG8_BAR; PG8_MMA(1, 0, At, B0); PG8_MMA(1, 1, At, B1); PG8_BAR; PG8_SCHED;
            PG8_LDB(B0, 1, 0); PG8_LDB(B1, 1, 1); PG8_SCHED; PG8_LDA(At, 1, 0); PG8_STAGE(PG8_SA(0, 1), a2 + hstep, voffA);
            PG8_WAIT_V(8); PG8_WAIT_L(0); PG8_BAR; PG8_MMA(0, 0, At, B0); PG8_MMA(0, 1, At, B1); PG8_BAR; PG8_SCHED;
            PG8_LDA(At, 1, 1); PG8_STAGE(PG8_SB(1, 0), b3, voffB); PG8_STAGE(PG8_SB(1, 1), b3 + hstep, voffB); PG8_STAGE(PG8_SA(1, 0), a3, voffA);
            PG8_WAIT_V(8); PG8_WAIT_L(0); PG8_BAR; PG8_MMA(1, 0, At, B0); PG8_MMA(1, 1, At, B1); PG8_BAR; PG8_SCHED;
            } else {
            PG8_LDB(B0, 0, 0); PG8_SCHED; PG8_LDA(At, 0, 0); PG8_STAGE(PG8_SA(1, 1), a1 + hstep, voffA);
            PG8_WAIT_L(8); PG8_BAR; PG8_WAIT_L(0); PG8_MMA(0, 0, At, B0); PG8_BAR; PG8_SCHED;
            PG8_LDB(B1, 0, 1); PG8_STAGE(PG8_SB(0, 0), b2, voffB);
            PG8_BAR; PG8_WAIT_L(0); PG8_MMA(0, 1, At, B1); PG8_BAR;
            PG8_LDA(At, 0, 1); PG8_STAGE(PG8_SA(0, 0), a2, voffA);
            PG8_BAR; PG8_WAIT_L(0); PG8_MMA(1, 0, At, B0); PG8_BAR; PG8_SCHED;
            PG8_STAGE(PG8_SB(0, 1), b2 + hstep, voffB);
            PG8_WAIT_V(6); PG8_BAR; PG8_MMA(1, 1, At, B1); PG8_BAR;
            PG8_LDB(B0, 1, 0); PG8_SCHED; PG8_LDA(At, 1, 0); PG8_STAGE(PG8_SA(0, 1), a2 + hstep, voffA);
            PG8_WAIT_L(8); PG8_BAR; PG8_WAIT_L(0); PG8_MMA(0, 0, At, B0); PG8_BAR; PG8_SCHED;
            PG8_LDB(B1, 1, 1); PG8_STAGE(PG8_SB(1, 0), b3, voffB);
            PG8_BAR; PG8_WAIT_L(0); PG8_MMA(0, 1, At, B1); PG8_BAR;
            PG8_LDA(At, 1, 1); PG8_STAGE(PG8_SA(1, 0), a3, voffA);
            PG8_BAR; PG8_WAIT_L(0); PG8_MMA(1, 0, At, B0); PG8_BAR; PG8_SCHED;
            PG8_STAGE(PG8_SB(1, 1), b3 + hstep, voffB);
            PG8_WAIT_V(6); PG8_BAR; PG8_MMA(1, 1, At, B1); PG8_BAR;
            }
        }
        if constexpr (ALIGN_EPI) { if (wr == 0) PG8_BAR; }
        if constexpr (!Epi::AFTER_DRAIN) { E(acc, cur, wr, wc, fr, fq); S.done(cur); }
        if (!has_next) break;
#pragma unroll
        for (int a = 0; a < 2; ++a)
#pragma unroll
            for (int b = 0; b < 2; ++b)
#pragma unroll
                for (int m = 0; m < 4; ++m)
#pragma unroll
                    for (int n = 0; n < 2; ++n) acc[a][b][m][n] = (f32x4){0.f, 0.f, 0.f, 0.f};
        cur = nxt; cA = nA; cB = nB; ++ui;
        if constexpr (ALIGN_EPI) { if (wr == 1) PG8_BAR; }
    }
    PG8_WAIT_V(0);
    if constexpr (!ALIGN_EPI) { if (wr == 0) PG8_BAR; }
    PG8_BAR;
    if constexpr (Epi::AFTER_DRAIN) { E.fused(acc, cur, wr, wc, fr, fq, lds, wid, lane); S.done(cur); }
#undef PG8_SA
#undef PG8_SB
#undef PG8_STAGE
#undef PG8_LDA
#undef PG8_LDB
#undef PG8_MMA
#undef PG8_WAIT_V
#undef PG8_WAIT_L
#undef PG8_BAR
#undef PG8_SCHED
}
}
namespace attn_body {
using bf16=__hip_bfloat16;
using bf16x8=__attribute__((ext_vector_type(8)))short;
using s16x4=__attribute__((ext_vector_type(4)))short;
using f32x16=__attribute__((ext_vector_type(16)))float;
using u32x4=__attribute__((ext_vector_type(4)))unsigned;
constexpr int BATCH=2,NHEAD=8,SEQ=8192,D=64,DM=NHEAD*D;
constexpr int NW=8,QBLK=32,QB=QBLK*NW,KVBLK=64,NQB=SEQ/QB;
constexpr int ATTN_PITCH=DM, ATTN_UNIT_ROWS=QB;
__device__ __forceinline__ int crow(int r,int hi){return (r&3)+8*(r>>2)+4*hi;}
#define SBAR() __builtin_amdgcn_sched_barrier(0)
__device__ __forceinline__ void cmask(f32x16&p0,f32x16&p1,int jb,int qrel,int hi){
  const float NEG=-INFINITY; int kb=64*jb+4*hi;
  #pragma unroll
  for(int r=0;r<16;++r){int kv=kb+(r&3)+8*(r>>2); if(kv>qrel)p0[r]=NEG; if(kv+32>qrel)p1[r]=NEG;}
}

__device__ __forceinline__ void smask(f32x16&p0,f32x16&p1,unsigned long long w,int hi,float mh){
  const unsigned lo=((unsigned)w)>>(4*hi), hh=((unsigned)(w>>32))>>(4*hi);
  if(__builtin_expect(__any(mh!=0.f),0)){
    #pragma unroll
    for(int r=0;r<16;++r){p0[r]-=mh;p1[r]-=mh;} }
  #pragma unroll
  for(int r=0;r<16;++r){ const unsigned bit=(unsigned)((r&3)+8*(r>>2));
    const unsigned t0=(unsigned)__builtin_amdgcn_sbfe((int)lo,bit,1u), t1=(unsigned)__builtin_amdgcn_sbfe((int)hh,bit,1u);
    float x0=p0[r],x1=p1[r];
    asm("v_bfi_b32 %0, %1, %0, %2":"+v"(x0):"v"(t0),"s"(0xFF800000u));
    asm("v_bfi_b32 %0, %1, %0, %2":"+v"(x1):"v"(t1),"s"(0xFF800000u));
    p0[r]=x0; p1[r]=x1; }
}
constexpr int NSLOT=3, SLOTB=8192;
constexpr int LDS_K=0, LDS_V=NSLOT*SLOTB, LDS_WS=2*NSLOT*SLOTB, LDS_OST=LDS_WS+NW*64*4, LDS_BYTES=LDS_OST+NW*4096;
constexpr float C2=0.125f*1.4426950408889634f;
__device__ __forceinline__ void glds16(const void*gsrc,unsigned lds_dst){unsigned keep;
  asm volatile("s_mov_b32 %0, m0\n\ts_mov_b32 m0, %2\n\ts_nop 0\n\tglobal_load_lds_dwordx4 %1, off\n\ts_mov_b32 m0, %0":"=&s"(keep):"v"(gsrc),"s"(lds_dst):"memory");}
__device__ __forceinline__ float max3f(float a,float b,float c){float r;asm("v_max3_f32 %0, %1, %2, %3":"=v"(r):"v"(a),"v"(b),"v"(c));return r;}
__device__ __forceinline__ float max2f(float a,float b){float r;asm("v_max_f32_e32 %0, %1, %2":"=v"(r):"v"(a),"v"(b));return r;}
__device__ __forceinline__ float fadd_s(float a,float b){float r;asm("v_add_f32_e32 %0, %1, %2":"=v"(r):"v"(a),"v"(b));return r;}
__device__ __forceinline__ float fsub_s(float a,float b){float r;asm("v_sub_f32_e32 %0, %1, %2":"=v"(r):"v"(a),"v"(b));return r;}
typedef float f32x2_t __attribute__((ext_vector_type(2))); typedef __bf16 bf16x2_t __attribute__((ext_vector_type(2)));
__device__ __forceinline__ unsigned cvtpk_s(float lo,float hi){f32x2_t v={lo,hi};bf16x2_t b=__builtin_convertvector(v,bf16x2_t);return __builtin_bit_cast(unsigned,b);}
#define WAIT_BAR(N) asm volatile("s_waitcnt vmcnt(" #N ") lgkmcnt(0)\n\ts_barrier":::"memory")

__device__ __forceinline__ void qkt(f32x16&p0,f32x16&p1,const char*Kslot,const bf16x8*qr,int r32,int hi){ const f32x16 negm=f32x16{};
  const char*kb=Kslot+hi*1024+r32*16;
  #pragma unroll
  for(int d0=0;d0<4;++d0){
    const bf16x8 b0=*reinterpret_cast<const bf16x8*>(kb+d0*2048);
    const bf16x8 b1=*reinterpret_cast<const bf16x8*>(kb+d0*2048+512);
    if(d0==0){p0=__builtin_amdgcn_mfma_f32_32x32x16_bf16(b0,qr[0],negm,0,0,0);p1=__builtin_amdgcn_mfma_f32_32x32x16_bf16(b1,qr[0],negm,0,0,0);}
    else{p0=__builtin_amdgcn_mfma_f32_32x32x16_bf16(b0,qr[d0],p0,0,0,0);p1=__builtin_amdgcn_mfma_f32_32x32x16_bf16(b1,qr[d0],p1,0,0,0);}}
}
typedef __attribute__((address_space(3))) const char* lds_cptr;
typedef short v4i16_t __attribute__((ext_vector_type(4)));
__device__ __forceinline__ void kload8(bf16x8*kf,lds_cptr kp){
  kf[0]=*(const __attribute__((address_space(3))) bf16x8*)(kp);      kf[1]=*(const __attribute__((address_space(3))) bf16x8*)(kp+512);
  kf[2]=*(const __attribute__((address_space(3))) bf16x8*)(kp+2048); kf[3]=*(const __attribute__((address_space(3))) bf16x8*)(kp+2560);
  kf[4]=*(const __attribute__((address_space(3))) bf16x8*)(kp+4096); kf[5]=*(const __attribute__((address_space(3))) bf16x8*)(kp+4608);
  kf[6]=*(const __attribute__((address_space(3))) bf16x8*)(kp+6144); kf[7]=*(const __attribute__((address_space(3))) bf16x8*)(kp+6656);
}
__device__ __forceinline__ void kload2(bf16x8*kf,lds_cptr kp,int j){ kf[2*j]=*(const __attribute__((address_space(3))) bf16x8*)(kp+j*2048); kf[2*j+1]=*(const __attribute__((address_space(3))) bf16x8*)(kp+j*2048+512); }
__device__ __forceinline__ s16x4 vtr(lds_cptr p){ return __builtin_bit_cast(s16x4,__builtin_amdgcn_ds_read_tr16_b64_v4i16((__attribute__((address_space(3))) v4i16_t*)p)); }
__device__ __forceinline__ float rowmax(const f32x16&p0,const f32x16&p1){
  float a=max3f(p0[0],p0[1],p1[0]),b=max3f(p0[2],p0[3],p1[1]);a=max3f(a,p1[2],p1[3]);
  #pragma unroll
  for(int r=4;r<16;r+=4){a=max3f(a,p0[r],p0[r+1]);b=max3f(b,p0[r+2],p0[r+3]);a=max3f(a,p1[r],p1[r+1]);b=max3f(b,p1[r+2],p1[r+3]);}
  const float m=max2f(a,b);
  auto rr=__builtin_amdgcn_permlane32_swap(__float_as_uint(m),__float_as_uint(m),false,false);
  return max2f(__uint_as_float(rr[0]),__uint_as_float(rr[1]));
}
__device__ __forceinline__ void pv(f32x16*o,int vb,bf16x8 pa0,bf16x8 pa1,bf16x8 pa2,bf16x8 pa3){
  #pragma unroll
  for(int d0=0;d0<2;++d0){s16x4 lo[4],hi[4];
    #pragma unroll
    for(int ks=0;ks<4;++ks){
      asm volatile("ds_read_b64_tr_b16 %0,%1 offset:%c2":"=&v"(lo[ks]):"v"(vb),"i"(d0*4096+ks*1024):"memory");
      asm volatile("ds_read_b64_tr_b16 %0,%1 offset:%c2":"=&v"(hi[ks]):"v"(vb),"i"(d0*4096+ks*1024+512):"memory");}
    asm volatile("s_waitcnt lgkmcnt(0)":::"memory");SBAR();
    #define PK(k) (bf16x8){lo[k][0],lo[k][1],lo[k][2],lo[k][3],hi[k][0],hi[k][1],hi[k][2],hi[k][3]}
    o[d0]=__builtin_amdgcn_mfma_f32_32x32x16_bf16(pa0,PK(0),o[d0],0,0,0);
    o[d0]=__builtin_amdgcn_mfma_f32_32x32x16_bf16(pa1,PK(1),o[d0],0,0,0);
    o[d0]=__builtin_amdgcn_mfma_f32_32x32x16_bf16(pa2,PK(2),o[d0],0,0,0);
    o[d0]=__builtin_amdgcn_mfma_f32_32x32x16_bf16(pa3,PK(3),o[d0],0,0,0);
    #undef PK
  }
}

#ifndef ATTN_STORE16
#define ATTN_STORE16(p,v) (*(u32x4*)(p)=(v))
#endif
template<int THRL> __device__ __forceinline__ void attn_unit(int b,int h,int qb,const bf16*Q,const bf16*__restrict__ K,const bf16*__restrict__ V,bf16*O,const unsigned long long*MT,char*shm){
  const int tid=threadIdx.x,lane=tid&63,r32=lane&31,hi=lane>>5; const int wid=__builtin_amdgcn_readfirstlane(tid>>6);
  const long rowbase=(long)b*SEQ; const int q0=qb*QB;
  const bf16*Qw=Q+(rowbase+q0+wid*QBLK)*DM+h*D;
  const bf16*Kh=K+rowbase*DM+h*D,*Vh=V+rowbase*DM+h*D;
  const unsigned lds0=(unsigned)(uintptr_t)shm;
  float*wsf=(float*)(shm+LDS_WS)+wid*64;
  const bf16*ksrc=Kh+(long)lane*DM+wid*8;
  const bf16*vsrc=Vh+(long)(16*(wid&3)+(lane>>2))*DM+(wid>>2)*32+(lane&3)*8;
  const unsigned kdst=lds0+LDS_K+wid*1024, vdst=lds0+LDS_V+wid*1024;
  #define DMA_K(t,slot) glds16(ksrc+(long)(t)*KVBLK*DM,(unsigned)__builtin_amdgcn_readfirstlane(kdst+(slot)))
  #define DMA_V(t,slot) glds16(vsrc+(long)(t)*KVBLK*DM,(unsigned)__builtin_amdgcn_readfirstlane(vdst+(slot)))
  const int vb0=(int)(lds0+LDS_V)+((lane>>4)&1)*32+(lane&3)*8+(4*hi+((lane&15)>>2))*64;
  const char*Kbase=shm+LDS_K; bf16x8 kf[8];
  const lds_cptr shm3=(lds_cptr)shm; const lds_cptr kp0=shm3+LDS_K+hi*1024+r32*16; const lds_cptr vp0=shm3+LDS_V+((lane>>4)&1)*32+(lane&3)*8+(4*hi+((lane&15)>>2))*64;
  const int NT=(q0+QB)/KVBLK;
  const unsigned long long*mrow=MT+((long)b*128)*SEQ+q0+wid*QBLK;
  unsigned long long mkA,mkB;
  #define MLOAD(var,t) asm volatile("global_load_dwordx2 %0, %1, %2":"=v"(var):"v"(r32*8),"s"(mrow+(long)(t)*SEQ):"memory")
  #define SMASK(P0,P1,var) do{ asm volatile("":"+v"(var)); smask(P0,P1,var,hi,mhat); }while(0)
  MLOAD(mkA,0);
  DMA_K(0,0);DMA_V(0,0);DMA_K(1,SLOTB);
  bf16x8 qr[4];
  #pragma unroll
  for(int d0=0;d0<4;++d0)qr[d0]=*reinterpret_cast<const bf16x8*>(&Qw[(long)r32*DM+d0*16+hi*8]);
  float mhat=0.f,l_reg=0.f;f32x16 o[2];o[0]=f32x16{};o[1]=f32x16{};
  const int qrel=wid*QBLK+r32;
  bool resc=false;
  #define START(P0,P1) do{ float rm=0.f; if constexpr(THRL<1000){ rm=rowmax(P0,P1); } resc=false; \
    { const float dl=(THRL<1000&&rm>(float)THRL)?rm:0.f; mhat=fadd_s(mhat,dl); \
      _Pragma("unroll") for(int r=0;r<16;++r){P0[r]=fsub_s(P0[r],dl);P1[r]=fsub_s(P1[r],dl);} } \
    _Pragma("unroll") for(int r=0;r<16;++r)P0[r]=__builtin_amdgcn_exp2f(P0[r]); }while(0)
  #define RESC() do{ if(resc){ asm volatile("s_waitcnt lgkmcnt(0)":::"memory"); \
      _Pragma("unroll") for(int d_=0;d_<2;++d_) _Pragma("unroll") for(int r=0;r<16;++r)o[d_][r]*=wsf[crow(r,hi)]; } }while(0)
  f32x16 pA0,pA1,pB0,pB1;
  int sl_prev=0,sl_cur=0,sl_next=SLOTB;
  #define ROT() do{sl_prev=sl_cur;sl_cur=sl_next;sl_next=(sl_next==(NSLOT-1)*SLOTB)?0:sl_next+SLOTB;}while(0)
  DMA_K(2,2*SLOTB);
  WAIT_BAR(3);
  qkt(pA0,pA1,Kbase,qr,r32,hi);asm volatile("s_nop 15\n\ts_nop 7":"+v"(pA0),"+v"(pA1));SMASK(pA0,pA1,mkA);
  START(pA0,pA1);
  _Pragma("unroll") for(int r=0;r<16;++r)pA1[r]=__builtin_amdgcn_exp2f(pA1[r]);
  WAIT_BAR(0);
  MLOAD(mkB,1);
  DMA_K(3,0);DMA_V(1,SLOTB);
  ROT();
  kload8(kf,kp0+sl_cur);
  WAIT_BAR(2);
  s16x4 vlo[8],vhi[8]; u32x4 pw0,pw1,pw2,pw3;
  #define PKW(P,B) cvtpk_s(P[B],P[B+1])
  #define PAF(k) __builtin_bit_cast(bf16x8,pw##k)
  #define VFR(i) (bf16x8){vlo[i][0],vlo[i][1],vlo[i][2],vlo[i][3],vhi[i][0],vhi[i][1],vhi[i][2],vhi[i][3]}
  #define PIN(x) asm volatile("":"+v"(x))
  #define MX3(a,b,c) __builtin_fmaxf(__builtin_fmaxf((a),(b)),(c))
  #define GAPA(MF,A0,A1,A2,A3,W0,W1,PW) do{ MF; sacc+=A0; sacc+=A1; sacc+=A2; sacc+=A3; PIN(sacc); W0; W1; PIN(PW); SBAR(); }while(0)
  #define EX(v) __builtin_amdgcn_exp2f(v)
  #define GAPB(MF,X,B) do{ MF; X[B]=EX(X[B]); X[B+1]=EX(X[B+1]); X[B+2]=EX(X[B+2]); X[B+3]=EX(X[B+3]); PIN(X); SBAR(); }while(0)
  #define VRD(i) do{ vlo[i]=vtr(vp_+(((i)>>2)*4096+((i)&3)*1024)); vhi[i]=vtr(vp_+(((i)>>2)*4096+((i)&3)*1024+512)); }while(0)
  #define KRD(G,j) do{ if(G){ kload2(kf,kp0+sl_next,j); SBAR(); } }while(0)
  #define STEP(C0,C1,P0,P1,t,GK,GV,GL,MKC,MKN) do{ SBAR(); \
    const lds_cptr vp_=vp0+sl_prev; \
    VRD(0); SBAR(); float sacc=(P0[0]+P0[1]); \
    GAPA(C0=__builtin_amdgcn_mfma_f32_32x32x16_bf16(kf[0],qr[0],f32x16{},0,0,0), P0[2],P0[3],P0[4],P0[5],     pw0[0]=PKW(P0,0), pw0[1]=PKW(P0,2), pw0); \
    VRD(4); SBAR(); GAPA(C1=__builtin_amdgcn_mfma_f32_32x32x16_bf16(kf[1],qr[0],f32x16{},0,0,0), P0[6],P0[7],P0[8],P0[9],     pw0[2]=PKW(P0,4), pw0[3]=PKW(P0,6), pw0); \
    VRD(1); SBAR(); GAPA(C0=__builtin_amdgcn_mfma_f32_32x32x16_bf16(kf[2],qr[1],C0,0,0,0),   P0[10],P0[11],P0[12],P0[13], pw1[0]=PKW(P0,8), pw1[1]=PKW(P0,10), pw1); \
    VRD(5); SBAR(); GAPA(C1=__builtin_amdgcn_mfma_f32_32x32x16_bf16(kf[3],qr[1],C1,0,0,0),   P0[14],P0[15],P1[0],P1[1],   pw1[2]=PKW(P0,12),pw1[3]=PKW(P0,14), pw1); \
    VRD(2); SBAR(); GAPA(C0=__builtin_amdgcn_mfma_f32_32x32x16_bf16(kf[4],qr[2],C0,0,0,0),   P1[2],P1[3],P1[4],P1[5],     pw2[0]=PKW(P1,0), pw2[1]=PKW(P1,2), pw2); \
    VRD(6); SBAR(); GAPA(C1=__builtin_amdgcn_mfma_f32_32x32x16_bf16(kf[5],qr[2],C1,0,0,0),   P1[6],P1[7],P1[8],P1[9],     pw2[2]=PKW(P1,4), pw2[3]=PKW(P1,6), pw2); \
    VRD(3); SBAR(); GAPA(C0=__builtin_amdgcn_mfma_f32_32x32x16_bf16(kf[6],qr[3],C0,0,0,0),   P1[10],P1[11],P1[12],P1[13], pw3[0]=PKW(P1,8), pw3[1]=PKW(P1,10), pw3); \
    VRD(7); SBAR(); GAPA(C1=__builtin_amdgcn_mfma_f32_32x32x16_bf16(kf[7],qr[3],C1,0,0,0),   P1[14],P1[15],0.f,0.f,       pw3[2]=PKW(P1,12),pw3[3]=PKW(P1,14), pw3); \
    l_reg+=sacc; \
    if((t)+1<NT){MLOAD(MKN,(t)+1);} if(GK){DMA_K((t)+3,sl_cur);} if(GV){DMA_V((t)+1,sl_next);} \
    SMASK(C0,C1,MKC); \
    resc=false; if constexpr(THRL<1000){ float a=MX3(C0[0],C0[1],C1[0]),b=MX3(C0[2],C0[3],C1[1]); a=MX3(a,C1[2],C1[3]); \
      _Pragma("unroll") for(int r=4;r<16;r+=4){a=MX3(a,C0[r],C0[r+1]);b=MX3(b,C0[r+2],C0[r+3]);a=MX3(a,C1[r],C1[r+1]);b=MX3(b,C1[r+2],C1[r+3]);} \
      float rm=__builtin_fmaxf(a,b); { auto rr=__builtin_amdgcn_permlane32_swap(__float_as_uint(rm),__float_as_uint(rm),false,false); rm=__builtin_fmaxf(__uint_as_float(rr[0]),__uint_as_float(rr[1])); } \
      if(__builtin_expect(__any(rm>(float)THRL),0)){ const float dl=__builtin_fmaxf(rm,0.f); mhat+=dl; \
        _Pragma("unroll") for(int r=0;r<16;++r){C0[r]-=dl;C1[r]-=dl;} \
        const float f=__builtin_amdgcn_exp2f(-dl); l_reg*=f; if(hi==0)wsf[r32]=f; resc=true; } } \
    SBAR(); \
    GAPB(o[0]=__builtin_amdgcn_mfma_f32_32x32x16_bf16(PAF(0),VFR(0),o[0],0,0,0), C0,0); \
    GAPB(o[1]=__builtin_amdgcn_mfma_f32_32x32x16_bf16(PAF(0),VFR(4),o[1],0,0,0), C0,4); \
    KRD(GL,0); GAPB(o[0]=__builtin_amdgcn_mfma_f32_32x32x16_bf16(PAF(1),VFR(1),o[0],0,0,0), C0,8); \
    KRD(GL,1); GAPB(o[1]=__builtin_amdgcn_mfma_f32_32x32x16_bf16(PAF(1),VFR(5),o[1],0,0,0), C0,12); \
    KRD(GL,2); GAPB(o[0]=__builtin_amdgcn_mfma_f32_32x32x16_bf16(PAF(2),VFR(2),o[0],0,0,0), C1,0); \
    KRD(GL,3); GAPB(o[1]=__builtin_amdgcn_mfma_f32_32x32x16_bf16(PAF(2),VFR(6),o[1],0,0,0), C1,4); \
    GAPB(o[0]=__builtin_amdgcn_mfma_f32_32x32x16_bf16(PAF(3),VFR(3),o[0],0,0,0), C1,8); \
    GAPB(o[1]=__builtin_amdgcn_mfma_f32_32x32x16_bf16(PAF(3),VFR(7),o[1],0,0,0), C1,12); \
    }while(0)
  int t=1;
  for(;t+5<NT;t+=2){
    STEP(pB0,pB1,pA0,pA1,t,true,true,true,mkB,mkA);     WAIT_BAR(2); RESC(); ROT();
    STEP(pA0,pA1,pB0,pB1,t+1,true,true,true,mkA,mkB);   WAIT_BAR(2); RESC(); ROT();
  }
  #define ENDW(tt) do{ if((tt)+3<NT){WAIT_BAR(2);} else if((tt)+2<NT){WAIT_BAR(1);} else {WAIT_BAR(0);} }while(0)
  for(;t+1<NT;t+=2){
    STEP(pB0,pB1,pA0,pA1,t,(t+3<NT),(t+1<NT),(t+1<NT),mkB,mkA);       ENDW(t);   RESC(); ROT();
    STEP(pA0,pA1,pB0,pB1,t+1,(t+4<NT),(t+2<NT),(t+2<NT),mkA,mkB);     ENDW(t+1); RESC(); ROT();
  }
  STEP(pB0,pB1,pA0,pA1,NT-1,false,false,false,mkB,mkA); RESC();
  { float sacc=pB0[0]+pB0[1]; _Pragma("unroll") for(int r=2;r<16;++r)sacc+=pB0[r]; _Pragma("unroll") for(int r=0;r<16;++r)sacc+=pB1[r]; l_reg+=sacc;
    pw0=(u32x4){PKW(pB0,0),PKW(pB0,2),PKW(pB0,4),PKW(pB0,6)};pw1=(u32x4){PKW(pB0,8),PKW(pB0,10),PKW(pB0,12),PKW(pB0,14)};pw2=(u32x4){PKW(pB1,0),PKW(pB1,2),PKW(pB1,4),PKW(pB1,6)};pw3=(u32x4){PKW(pB1,8),PKW(pB1,10),PKW(pB1,12),PKW(pB1,14)};
    SBAR(); pv(o,vb0+sl_cur,PAF(0),PAF(1),PAF(2),PAF(3)); }
  #undef PKW
  #undef PAF
  #undef VFR
  #undef PIN
  #undef MX3
  #undef GAPA
  #undef GAPB
  #undef EX
  #undef VRD
  #undef KRD
  #undef STEP
  #undef ENDW
  {auto rr=__builtin_amdgcn_permlane32_swap(__float_as_uint(l_reg),__float_as_uint(l_reg),false,false);l_reg=__uint_as_float(rr[0])+__uint_as_float(rr[1]);}
  if(hi==0)wsf[32+r32]=l_reg;asm volatile("s_waitcnt lgkmcnt(0)":::"memory");
  float rli[16];
  #pragma unroll
  for(int r=0;r<16;++r)rli[r]=__builtin_amdgcn_rcpf(wsf[32+crow(r,hi)]);
  bf16*Ow=O+(rowbase+q0+wid*QBLK)*DM+h*D;
  { bf16*stg=(bf16*)(shm+LDS_OST)+wid*2048;
    #pragma unroll
    for(int r=0;r<16;++r){const int orow=crow(r,hi);
      #pragma unroll
      for(int d0=0;d0<2;++d0)((_Float16*)stg)[orow*64+d0*32+r32]=(_Float16)(o[d0][r]*rli[r]);}
    asm volatile("s_waitcnt lgkmcnt(0)":::"memory");
    #pragma unroll
    for(int i=0;i<4;++i){const int row=i*8+(lane>>3),ch=lane&7; const u32x4 v=*(const u32x4*)(stg+row*64+ch*8); ATTN_STORE16(Ow+(long)row*DM+ch*8,v);} }
  asm volatile("s_waitcnt lgkmcnt(0)\n\ts_barrier":::"memory");
  #undef DMA_K
  #undef DMA_V
  #undef MLOAD
  #undef SMASK
  #undef START
  #undef RESC
  #undef ROT
}
constexpr int ATTN_LDS_BYTES=LDS_BYTES;
struct AttnTensors { const bf16* Q; const bf16* K; const bf16* V; bf16* O; const unsigned long long* MT; };
struct AttnUnit { int bh; int qb; };
struct StaticOrder {
  int vcu,grid,blk;
  __device__ __forceinline__ explicit StaticOrder(int grid_,int block):vcu((block%8)*(grid_/8)+block/8),grid(grid_),blk(block){}
  __device__ __forceinline__ bool next(int i,AttnUnit&u)const{
    if(grid!=256){ const int k=i*grid+blk; if(k>=16*NQB)return false; u.bh=k/NQB; u.qb=NQB-1-(k%NQB); return true; }
    if(i>=2)return false; const int s=vcu&15; u.bh=vcu>>4; u.qb=(i==0)?s:31-s; return true; }
  __device__ __forceinline__ void a_ready(const AttnUnit&)const{}
  __device__ __forceinline__ void done(const AttnUnit&)const{}
};
template<class Sched,int THRL=64> __device__ __forceinline__ void attn_phase(char*lds,const AttnTensors&T,const Sched&S,bool safe){
  AttnUnit u;
  for(int i=0;S.next(i,u);++i){ S.a_ready(u); if(safe) attn_unit<1000>(u.bh/NHEAD,u.bh%NHEAD,u.qb,T.Q,T.K,T.V,T.O,T.MT,lds); else attn_unit<THRL>(u.bh/NHEAD,u.bh%NHEAD,u.qb,T.Q,T.K,T.V,T.O,T.MT,lds); S.done(u); }
}
#undef SBAR
#undef WAIT_BAR
}


#define LAS __attribute__((address_space(3)))
#define GAS __attribute__((address_space(1)))
typedef _Float16 f16;
typedef _Float16 h2 __attribute__((ext_vector_type(2)));
typedef _Float16 h8 __attribute__((ext_vector_type(8)));
typedef float f32x4 __attribute__((ext_vector_type(4)));
typedef float f32x8 __attribute__((ext_vector_type(8)));
typedef float f32x16 __attribute__((ext_vector_type(16)));
typedef unsigned u32x4 __attribute__((ext_vector_type(4)));

constexpr int TT = 16384, SEQ = 8192, DM = 1024, INW = 5192, DFF = 2816, NW = 8;
constexpr float EPS = 1e-6f;
constexpr size_t MiB = 1u << 20;
constexpr size_t WS_W1T = 2 * MiB, WS_WAOT = 13 * MiB, WS_WCOT = 14 * MiB, WS_WOUTT = 15 * MiB, WS_WGUT = 17 * MiB, WS_WDT = 28 * MiB, WS_WPGT = 34 * MiB, WS_WPPT = 36 * MiB;
constexpr size_t WS_SS1 = 37 * MiB, WS_SS2 = 38 * MiB;
constexpr size_t WS_MASK = 56 * MiB;
constexpr size_t WS_H = 40 * MiB, WS_CONV = 40 * MiB, WS_X2H = 40 * MiB;
constexpr size_t WS_Q = 72 * MiB, WS_K = 88 * MiB, WS_MERGED = 72 * MiB, WS_TMP = 72 * MiB;
constexpr size_t WS_V = 104 * MiB, WS_QI = 120 * MiB, WS_X1H = 104 * MiB;
constexpr size_t WS_KI = 136 * MiB, WS_WI = 138 * MiB, WS_GLU = 140 * MiB, WS_GA = 156 * MiB, WS_GC = 188 * MiB, WS_SEL = 220 * MiB, WS_ACT = 136 * MiB;
constexpr size_t WS_ATT = 228 * MiB, WS_P16 = 244 * MiB, WS_END = 252 * MiB;
constexpr int N1 = 21 * 256, NGU = 22 * 256;
constexpr int LDS_BYTES = 148480;

struct Params { const float* in[20]; float* out; unsigned char* ws; };
typedef const __attribute__((address_space(4))) Params* KP;

__device__ __forceinline__ h8 pack8(f32x4 a, f32x4 b) {
    f32x8 v = {a[0], a[1], a[2], a[3], b[0], b[1], b[2], b[3]};
    return __builtin_convertvector(v, h8);
}
typedef __bf16 bf2v __attribute__((ext_vector_type(2)));
typedef float f32x2v __attribute__((ext_vector_type(2)));
__device__ __forceinline__ unsigned pkbf(float lo, float hi) { f32x2v v = {lo, hi}; return __builtin_bit_cast(unsigned, __builtin_convertvector(v, bf2v)); }
__device__ __forceinline__ u32x4 pack8_bf16(f32x4 a, f32x4 b) { return (u32x4){pkbf(a[0], a[1]), pkbf(a[2], a[3]), pkbf(b[0], b[1]), pkbf(b[2], b[3])}; }
__device__ __forceinline__ float sigm(float x) { return __builtin_amdgcn_rcpf(1.f + __expf(-x)); }
__device__ __forceinline__ f32x4 sigm4(f32x4 x) { f32x4 r; r[0] = sigm(x[0]); r[1] = sigm(x[1]); r[2] = sigm(x[2]); r[3] = sigm(x[3]); return r; }
__device__ __forceinline__ float wave_sum(float v) {
#pragma unroll
    for (int o = 1; o < 64; o <<= 1) v += __shfl_xor(v, o);
    return v;
}
__device__ __forceinline__ float sq4(f32x4 x) { return (x[0] * x[0] + x[1] * x[1]) + (x[2] * x[2] + x[3] * x[3]); }

struct EpiG1 {
    static constexpr bool PERM = true, AFTER_DRAIN = false;
    GAS unsigned char* wsb; const LAS float* gtab;
    __device__ __forceinline__ void operator()(const f32x4 (&acc)[2][2][4][2], const pg8::Unit& u, int wr, int wc, int fr, int fq) const {
        GAS f16* const Q = (GAS f16*)(wsb + WS_Q); GAS f16* const K = (GAS f16*)(wsb + WS_K); GAS f16* const V = (GAS f16*)(wsb + WS_V); GAS f16* const QI = (GAS f16*)(wsb + WS_QI); GAS f16* const KI = (GAS f16*)(wsb + WS_KI);
        GAS f16* const GLU = (GAS f16*)(wsb + WS_GLU); GAS f16* const GA = (GAS f16*)(wsb + WS_GA); GAS f16* const GC = (GAS f16*)(wsb + WS_GC); GAS float* const WI = (GAS float*)(wsb + WS_WI);
        const int row0 = u.pm * 256 + wr * 64 + fr;
        const int pn = u.pn;
        if (pn < 4) {
            const bool isq = pn < 2; const LAS float* g = gtab + (isq ? 0 : 64); GAS f16* O = isq ? Q : K;
            const int head = 4 * (pn & 1) + wc; const float sc = isq ? 0.125f * 1.4426950408889634f : 1.f;
            f32x4 gv[2][2];
#pragma unroll
            for (int bj = 0; bj < 2; ++bj)
#pragma unroll
                for (int n = 0; n < 2; ++n) gv[bj][n] = *(const LAS f32x4*)(g + 32 * bj + 8 * fq + 4 * n);
#pragma unroll
            for (int ai = 0; ai < 2; ++ai)
#pragma unroll
                for (int m = 0; m < 4; ++m) {
                    float ss = (sq4(acc[ai][0][m][0]) + sq4(acc[ai][0][m][1])) + (sq4(acc[ai][1][m][0]) + sq4(acc[ai][1][m][1]));
                    ss += __shfl_xor(ss, 16); ss += __shfl_xor(ss, 32);
                    const float rinv = __builtin_amdgcn_rsqf(ss * (1.f / 64.f) + EPS) * sc;
                    GAS f16* rowp = O + (size_t)(row0 + ai * 128 + m * 16) * 512 + head * 64 + 8 * fq;
#pragma unroll
                    for (int bj = 0; bj < 2; ++bj) *(GAS u32x4*)(rowp + 32 * bj) = pack8_bf16(acc[ai][bj][m][0] * rinv * gv[bj][0], acc[ai][bj][m][1] * rinv * gv[bj][1]);
                }
        } else if (pn < 8) {
            GAS f16* O = (pn < 6) ? V : QI; const float sc = (pn < 6) ? 1.f : 0.125f;
            const int col0 = 256 * (pn & 1) + 32 * wc + 8 * fq;
#pragma unroll
            for (int ai = 0; ai < 2; ++ai)
#pragma unroll
                for (int m = 0; m < 4; ++m) { GAS f16* rowp = O + (size_t)(row0 + ai * 128 + m * 16) * 512 + col0;
#pragma unroll
                    for (int bj = 0; bj < 2; ++bj) { if (pn < 6) *(GAS u32x4*)(rowp + 128 * bj) = pack8_bf16(acc[ai][bj][m][0], acc[ai][bj][m][1]); else *(GAS h8*)(rowp + 128 * bj) = pack8(acc[ai][bj][m][0] * sc, acc[ai][bj][m][1] * sc); } }
        } else if (pn == 8) {
#pragma unroll
            for (int ai = 0; ai < 2; ++ai)
#pragma unroll
                for (int m = 0; m < 4; ++m) { const size_t row = (size_t)(row0 + ai * 128 + m * 16);
                    if (wc < 2) *(GAS h8*)(KI + row * 64 + 32 * wc + 8 * fq) = pack8(acc[ai][0][m][0], acc[ai][0][m][1]);
                    else if (wc == 2 && fq == 0) { *(GAS f32x4*)(WI + row * 8) = acc[ai][0][m][0] * 0.35355339059f; *(GAS f32x4*)(WI + row * 8 + 4) = acc[ai][0][m][1] * 0.35355339059f; } }
        } else if (pn < 13) {
            const int col0 = 128 * (pn - 9) + 32 * wc + 8 * fq;
#pragma unroll
            for (int ai = 0; ai < 2; ++ai)
#pragma unroll
                for (int m = 0; m < 4; ++m)
                    *(GAS h8*)(GLU + (size_t)(row0 + ai * 128 + m * 16) * 512 + col0) = pack8(acc[ai][0][m][0] * sigm4(acc[ai][1][m][0]), acc[ai][0][m][1] * sigm4(acc[ai][1][m][1]));
        } else {
            GAS f16* O = (pn < 17) ? GA : GC; const int col0 = 256 * ((pn - 13) & 3) + 32 * wc + 8 * fq;
#pragma unroll
            for (int ai = 0; ai < 2; ++ai)
#pragma unroll
                for (int m = 0; m < 4; ++m) { GAS f16* rowp = O + (size_t)(row0 + ai * 128 + m * 16) * 1024 + col0;
#pragma unroll
                    for (int bj = 0; bj < 2; ++bj) *(GAS h8*)(rowp + 128 * bj) = pack8(sigm4(acc[ai][bj][m][0]), sigm4(acc[ai][bj][m][1])); }
        }
    }
};

__device__ __forceinline__ void h8_to_f(h8 v, f32x4& a, f32x4& b) {
    f32x8 f = __builtin_convertvector(v, f32x8);
    a = (f32x4){f[0], f[1], f[2], f[3]}; b = (f32x4){f[4], f[5], f[6], f[7]};
}

template <int MODE> struct EpiN {
    static constexpr bool PERM = true, AFTER_DRAIN = false;
    GAS f16* O16; const GAS f16* G16; const GAS float* RES; GAS float* OUT; GAS float* SSW; const GAS float* SSR; const GAS f16* R16;
    __device__ __forceinline__ void operator()(const f32x4 (&acc)[2][2][4][2], const pg8::Unit& u, int wr, int wc, int fr, int fq) const {
        const int row0 = u.pm * 256 + wr * 64 + fr, col0 = u.pn * 256 + 32 * wc + 8 * fq;
#pragma unroll
        for (int ai = 0; ai < 2; ++ai)
#pragma unroll
            for (int m = 0; m < 4; ++m) {
                const size_t row = (size_t)(row0 + ai * 128 + m * 16);
                float rstd = 1.f, ss = 0.f;
                if (MODE == 4) { const GAS f32x4* sp = (const GAS f32x4*)(SSR + row * 16); f32x4 s = (sp[0] + sp[1]) + (sp[2] + sp[3]);
                    rstd = __builtin_amdgcn_rsqf(((s[0] + s[1]) + (s[2] + s[3])) * (1.f / 1024.f) + EPS); }
#pragma unroll
                for (int bj = 0; bj < 2; ++bj) {
                    const size_t off = row * 1024 + col0 + 128 * bj;
                    const f32x4 a0 = acc[ai][bj][m][0], a1 = acc[ai][bj][m][1];
                    if (MODE == 0) { f32x4 g0, g1; h8_to_f(*(const GAS h8*)(G16 + off), g0, g1); *(GAS h8*)(O16 + off) = pack8(g0 * a0, g1 * a1); }
                    if (MODE == 1) { f32x4 g0, g1, p0, p1; h8_to_f(*(const GAS h8*)(G16 + off), g0, g1); h8_to_f(*(const GAS h8*)(O16 + off), p0, p1); *(GAS h8*)(O16 + off) = pack8(p0 + g0 * a0, p1 + g1 * a1); }
                    if (MODE == 2) { const f32x4 x0 = *(const GAS f32x4*)(RES + off) + a0, x1 = *(const GAS f32x4*)(RES + off + 4) + a1;
                        *(GAS h8*)(O16 + off) = pack8(x0, x1); ss += sq4(x0) + sq4(x1); }
                    if (MODE == 5) { f32x4 r0, r1; h8_to_f(*(const GAS h8*)(R16 + off), r0, r1); const f32x4 x0 = r0 + a0, x1 = r1 + a1;
                        *(GAS h8*)(O16 + off) = pack8(x0, x1); ss += sq4(x0) + sq4(x1); }
                    if (MODE == 3) { *(GAS h8*)(O16 + off) = pack8(a0, a1); }
                    if (MODE == 4) { f32x4 g0, g1; h8_to_f(*(const GAS h8*)(G16 + off), g0, g1);
                        f32x4 r0, r1; h8_to_f(*(const GAS h8*)(R16 + off), r0, r1);
                        const f32x4 x0 = r0 + sigm4(a0 * rstd) * g0, x1 = r1 + sigm4(a1 * rstd) * g1;
                        *(GAS f32x4*)(OUT + off) = x0; *(GAS f32x4*)(OUT + off + 4) = x1; }
                }
                if (MODE == 2 || MODE == 5) { ss += __shfl_xor(ss, 16); ss += __shfl_xor(ss, 32); if (fq == 0) SSW[row * 16 + u.pn * 4 + wc] = ss; }
                asm volatile("" ::: "memory");
            }
    }
};

struct EpiGU {
    static constexpr bool PERM = true, AFTER_DRAIN = false;
    GAS f16* ACT; const LAS float* tab; const LAS int* pml;
    __device__ __forceinline__ void operator()(const f32x4 (&acc)[2][2][4][2], const pg8::Unit& u, int wr, int wc, int fr, int fq) const {
        const int row0 = u.pm * 256 + wr * 64 + fr, col0 = u.pn * 128 + 32 * wc + 8 * fq;
        int slot = 0;
#pragma unroll
        for (int j = 1; j < 16; ++j) slot = (pml[j] == u.pm) ? j : slot;
        slot = (pml[0] == u.pm) ? 0 : slot;
        const LAS float* tb = tab + slot * 256 + wr * 64 + fr;
#pragma unroll
        for (int ai = 0; ai < 2; ++ai)
#pragma unroll
            for (int m = 0; m < 4; ++m) {
                const size_t row = (size_t)(row0 + ai * 128 + m * 16);
                const float rstd = tb[ai * 128 + m * 16];
                const f32x4 g0 = acc[ai][0][m][0] * rstd, g1 = acc[ai][0][m][1] * rstd, u0 = acc[ai][1][m][0] * rstd, u1 = acc[ai][1][m][1] * rstd;
                *(GAS h8*)(ACT + row * DFF + col0) = pack8(g0 * sigm4(g0) * u0, g1 * sigm4(g1) * u1);
                asm volatile("" ::: "memory");
            }
    }
};

__device__ __forceinline__ void tr_item(const GAS float* W, int ldn, int k0, int src0, GAS f16* WT, int K, int dst0, const GAS float* gk, LAS float* scr, int lane) {
    const GAS float* wp = W + (size_t)(k0 + (lane >> 5)) * ldn + src0 + (lane & 31);
    float v[32];
#pragma unroll
    for (int i = 0; i < 32; ++i) v[i] = wp[(size_t)(2 * i) * ldn];
    const int c = lane & 7;
    f32x4 g0 = {1.f, 1.f, 1.f, 1.f}, g1 = {1.f, 1.f, 1.f, 1.f};
    if (gk) { g0 = *(const GAS f32x4*)(gk + k0 + 8 * c); g1 = *(const GAS f32x4*)(gk + k0 + 8 * c + 4); }
    __builtin_amdgcn_sched_barrier(0);
#pragma unroll
    for (int i = 0; i < 32; ++i) scr[(2 * i + (lane >> 5)) * 33 + (lane & 31)] = v[i];
    asm volatile("s_waitcnt lgkmcnt(0)" ::: "memory");
#pragma unroll
    for (int j = 0; j < 4; ++j) { const int n = (lane >> 3) + 8 * j; const LAS float* s = scr + (8 * c) * 33 + n;
        f32x8 o = {s[0] * g0[0], s[33] * g0[1], s[66] * g0[2], s[99] * g0[3], s[132] * g1[0], s[165] * g1[1], s[198] * g1[2], s[231] * g1[3]};
        *(GAS h8*)(WT + (size_t)(dst0 + n) * K + k0 + 8 * c) = __builtin_convertvector(o, h8); }
    asm volatile("s_waitcnt lgkmcnt(0)" ::: "memory");
}

template <int MODE> __device__ __forceinline__ void phase0(KP P, LAS unsigned char* lds, int gw, int NGW, int wave, int lane) {
    GAS unsigned char* ws = ((GAS unsigned char*)P->ws);
    LAS float* scr = (LAS float*)(lds + wave * 16384);
    constexpr int I1 = 16 * 168, I2 = 8 * 32, I4 = 16 * 32, I5 = 16 * 176, I6 = 44 * 32, I7 = 16 * 32, I8 = 4 * 32;
    constexpr int NIT = I1 + 2 * I2 + I4 + I5 + I6 + I7 + I8;
    if (MODE & 5) for (int it = ((MODE & 1) ? 0 : I1) + gw; it < ((MODE & 4) ? NIT : I1); it += NGW) {
        int r = it;
        if (r < I1) { const int kb = r / 168, grp = r % 168, pn = grp >> 3, g = grp & 7; int src0;
            if (pn < 4) src0 = ((pn < 2) ? 0 : 512) + 64 * (4 * (pn & 1) + (g & 3)) + 32 * (g >> 2);
            else if (pn < 8) src0 = 1024 + 256 * (pn - 4) + 32 * g;
            else if (pn == 8) src0 = (g < 2) ? 2048 + 32 * g : 2112;
            else if (pn < 13) src0 = (g < 4) ? 2120 + 128 * (pn - 9) + 32 * g : 2632 + 128 * (pn - 9) + 32 * (g - 4);
            else src0 = 3144 + 256 * (pn - 13) + 32 * g;
            tr_item(((const GAS float*)P->in[3]), INW, 64 * kb, src0, (GAS f16*)(ws + WS_W1T), 1024, 32 * grp, nullptr, scr, lane); continue; } r -= I1;
        if (r < I2) { tr_item(((const GAS float*)P->in[10]), 1024, 64 * (r / 32), 32 * (r % 32), (GAS f16*)(ws + WS_WAOT), 512, 32 * (r % 32), nullptr, scr, lane); continue; } r -= I2;
        if (r < I2) { tr_item(((const GAS float*)P->in[11]), 1024, 64 * (r / 32), 32 * (r % 32), (GAS f16*)(ws + WS_WCOT), 512, 32 * (r % 32), nullptr, scr, lane); continue; } r -= I2;
        if (r < I4) { tr_item(((const GAS float*)P->in[12]), 1024, 64 * (r / 32), 32 * (r % 32), (GAS f16*)(ws + WS_WOUTT), 1024, 32 * (r % 32), nullptr, scr, lane); continue; } r -= I4;
        if (r < I5) { const int kb = r / 176, grp = r % 176, j = grp >> 3, g = grp & 7;
            tr_item((g < 4) ? ((const GAS float*)P->in[14]) : ((const GAS float*)P->in[15]), DFF, 64 * kb, 128 * j + 32 * (g & 3), (GAS f16*)(ws + WS_WGUT), 1024, 32 * grp, ((const GAS float*)P->in[13]), scr, lane); continue; } r -= I5;
        if (r < I6) { tr_item(((const GAS float*)P->in[16]), 1024, 64 * (r / 32), 32 * (r % 32), (GAS f16*)(ws + WS_WDT), DFF, 32 * (r % 32), nullptr, scr, lane); continue; } r -= I6;
        if (r < I7) { tr_item(((const GAS float*)P->in[18]), 1024, 64 * (r / 32), 32 * (r % 32), (GAS f16*)(ws + WS_WPGT), 1024, 32 * (r % 32), ((const GAS float*)P->in[17]), scr, lane); continue; } r -= I7;
        tr_item(((const GAS float*)P->in[19]), 1024, 64 * (r / 32), 32 * (r % 32), (GAS f16*)(ws + WS_WPPT), 256, 32 * (r % 32), nullptr, scr, lane);
    }
    const GAS float* gm = ((const GAS float*)P->in[2]);
    f32x4 gv[4];
#pragma unroll
    for (int j = 0; j < 4; ++j) gv[j] = *((const GAS f32x4*)gm + lane + 64 * j);
    if (MODE & 2) for (int m0 = gw; m0 < TT; m0 += 2 * NGW) {
        const int m1 = (m0 + NGW < TT) ? m0 + NGW : m0;
        f32x4 v[2][4]; f32x4 pv[2]; float s[2] = {0.f, 0.f};
#pragma unroll
        for (int u = 0; u < 2; ++u) { const int m = u ? m1 : m0; const GAS f32x4* xr = (const GAS f32x4*)(((const GAS float*)P->in[0]) + (size_t)m * DM) + lane;
#pragma unroll
            for (int j = 0; j < 4; ++j) v[u][j] = xr[64 * j];
            pv[u] = *((const GAS f32x4*)(((const GAS float*)P->in[1]) + (size_t)m * 256) + lane); }
#pragma unroll
        for (int u = 0; u < 2; ++u) {
            const int m = u ? m1 : m0;
#pragma unroll
            for (int j = 0; j < 4; ++j) s[u] += sq4(v[u][j]);
            const float rstd = __builtin_amdgcn_rsqf(wave_sum(s[u]) * (1.f / DM) + EPS);
            GAS f16* orow = (GAS f16*)(ws + WS_H) + (size_t)m * DM;
            typedef _Float16 h4 __attribute__((ext_vector_type(4)));
#pragma unroll
            for (int j = 0; j < 4; ++j) { f32x4 o = v[u][j] * rstd * gv[j]; *(GAS h4*)(orow + 4 * lane + 256 * j) = __builtin_convertvector(o, h4); }
            *(GAS h4*)((GAS f16*)(ws + WS_P16) + (size_t)m * 256 + 4 * lane) = __builtin_convertvector(pv[u], h4);
        }
    }
}

__device__ __forceinline__ void conv_phase(KP P, LAS unsigned char* lds, int gw, int NGW, int tid, int lane) {
    LAS float* cw = (LAS float*)lds;
    for (int i = tid; i < 31 * 512; i += 512) cw[i] = ((const GAS float*)P->in[6])[i];
    __syncthreads();
    const GAS f16* GLU = (const GAS f16*)(((GAS unsigned char*)P->ws) + WS_GLU); GAS f16* CONV = (GAS f16*)(((GAS unsigned char*)P->ws) + WS_CONV);
    const h8 zero8 = {0, 0, 0, 0, 0, 0, 0, 0};
    for (int ch = gw; ch < TT / 8; ch += NGW) {
        const int tok0 = 8 * ch, tl = tok0 & (SEQ - 1);
        float acc[8][8];
#pragma unroll
        for (int i = 0; i < 8; ++i)
#pragma unroll
            for (int c = 0; c < 8; ++c) acc[i][c] = 0.f;
        h8 buf[2][8];
#define CONV_LOAD(cc) do { _Pragma("unroll") for (int r = 0; r < 8; ++r) { const int rr = 8 * (cc) + r; if (rr < 38) { const int d = rr - 30; const bool ok = (tl + d >= 0); \
            const h8 x = *(const GAS h8*)(GLU + (size_t)(tok0 + (ok ? d : -tl)) * 512 + 8 * lane); buf[(cc) & 1][r] = ok ? x : zero8; } } } while (0)
        CONV_LOAD(0);
#pragma unroll
        for (int c = 0; c < 5; ++c) {
            __builtin_amdgcn_sched_barrier(0);
            if (c + 1 < 5) CONV_LOAD(c + 1);
            __builtin_amdgcn_sched_barrier(0);
#pragma unroll
            for (int r = 0; r < 8; ++r) {
                const int rr = 8 * c + r;
                if (rr < 38) {
                    const u32x4 xw = __builtin_bit_cast(u32x4, buf[c & 1][r]);
#pragma unroll
                    for (int i = 0; i < 8; ++i) {
                        const int j = rr - i;
                        if (j >= 0 && j <= 30) {
                            const f32x4 w0 = *(const LAS f32x4*)(cw + j * 512 + 8 * lane), w1 = *(const LAS f32x4*)(cw + j * 512 + 8 * lane + 4);
#pragma unroll
                            for (int e = 0; e < 4; ++e) { const float wl = (e < 2) ? w0[2 * e] : w1[2 * e - 4], wh = (e < 2) ? w0[2 * e + 1] : w1[2 * e - 3];
                                asm("v_fma_mix_f32 %0, %1, %2, %0 op_sel_hi:[0,1,0]" : "+v"(acc[i][2 * e]) : "v"(wl), "v"(xw[e]));
                                asm("v_fma_mix_f32 %0, %1, %2, %0 op_sel:[0,1,0] op_sel_hi:[0,1,0]" : "+v"(acc[i][2 * e + 1]) : "v"(wh), "v"(xw[e])); }
                        }
                    }
                }
            }
        }
#undef CONV_LOAD
        const f32x4 b0 = *(const GAS f32x4*)(((const GAS float*)P->in[7]) + 8 * lane), b1 = *(const GAS f32x4*)(((const GAS float*)P->in[7]) + 8 * lane + 4);
        const f32x4 g0 = *(const GAS f32x4*)(((const GAS float*)P->in[8]) + 8 * lane), g1 = *(const GAS f32x4*)(((const GAS float*)P->in[8]) + 8 * lane + 4);
        const f32x4 l0 = *(const GAS f32x4*)(((const GAS float*)P->in[9]) + 8 * lane), l1 = *(const GAS f32x4*)(((const GAS float*)P->in[9]) + 8 * lane + 4);
#pragma unroll
        for (int i = 0; i < 8; ++i) {
            f32x4 y0 = {acc[i][0], acc[i][1], acc[i][2], acc[i][3]}, y1 = {acc[i][4], acc[i][5], acc[i][6], acc[i][7]};
            y0 += b0; y1 += b1;
            const float mu = wave_sum((y0[0] + y0[1]) + (y0[2] + y0[3]) + (y1[0] + y1[1]) + (y1[2] + y1[3])) * (1.f / 512.f);
            y0 -= mu; y1 -= mu;
            const float rstd = __builtin_amdgcn_rsqf(wave_sum(sq4(y0) + sq4(y1)) * (1.f / 512.f) + EPS);
            y0 = y0 * rstd * g0 + l0; y1 = y1 * rstd * g1 + l1;
            *(GAS h8*)(CONV + (size_t)(tok0 + i) * 512 + 8 * lane) = pack8(y0 * sigm4(y0), y1 * sigm4(y1));
        }
    }
    __syncthreads();
}

__device__ __forceinline__ void find_bin(LAS unsigned* H, int lane, unsigned need, unsigned& bin, unsigned& rem) {
    const u32x4 h = *(const LAS u32x4*)(H + 4 * lane);
    const unsigned c4 = (h[0] + h[1]) + (h[2] + h[3]);
    unsigned S = c4;
#pragma unroll
    for (int o = 1; o < 64; o <<= 1) { const unsigned t = __shfl_down(S, o); if (lane + o < 64) S += t; }
    unsigned a = S - c4, fb = 0, fr = 0; bool found = false;
#pragma unroll
    for (int b = 3; b >= 0; --b) { const unsigned hb = h[b]; if (!found && a < need && a + hb >= need) { found = true; fb = 4 * lane + b; fr = need - a; } a += hb; }
    const unsigned long long mk = __ballot(found);
    const int src = mk ? (__ffsll((long long)mk) - 1) : 0;
    bin = __shfl(fb, src); rem = __shfl(fr, src);
}

template <int MODE> __device__ __forceinline__ void indexer_pair(LAS unsigned char* lds, const GAS f16* KI, int b, int t0, int ntiles, int tile, int n, int g,
        const h8 (&A)[2][4], const float (&w)[2][2][8], const h8 (&BA)[4], const h8 (&BB)[4], h8 (&NA)[4], h8 (&NB)[4]) {
    LAS unsigned short* KS = (LAS unsigned short*)lds;
        const bool hasB = tile + NW < ntiles;
        const int tna = (tile + 2 * NW < ntiles) ? tile + 2 * NW : tile, tnb = (tile + 3 * NW < ntiles) ? tile + 3 * NW : tna;
        const GAS h8* pa = (const GAS h8*)(KI + (size_t)(b * SEQ + tna * 32 + n) * 64 + 32 * g);
        const GAS h8* pb = (const GAS h8*)(KI + (size_t)(b * SEQ + tnb * 32 + n) * 64 + 32 * g);
        #pragma unroll
        for (int kk = 0; kk < 4; ++kk) { NA[kk] = pa[kk]; NB[kk] = pb[kk]; }
        f32x16 cA[2], cB[2];
#pragma unroll
        for (int mt = 0; mt < 2; ++mt) { cA[mt] = __builtin_amdgcn_mfma_f32_32x32x16_f16(A[mt][0], BA[0], f32x16{}, 0, 0, 0); cB[mt] = __builtin_amdgcn_mfma_f32_32x32x16_f16(A[mt][0], BB[0], f32x16{}, 0, 0, 0); }
#pragma unroll
        for (int kk = 1; kk < 4; ++kk)
#pragma unroll
            for (int mt = 0; mt < 2; ++mt) { cA[mt] = __builtin_amdgcn_mfma_f32_32x32x16_f16(A[mt][kk], BA[kk], cA[mt], 0, 0, 0); cB[mt] = __builtin_amdgcn_mfma_f32_32x32x16_f16(A[mt][kk], BB[kk], cB[mt], 0, 0, 0); }
#pragma unroll
        for (int u = 0; u < 2; ++u) {
            const int s = (tile + u * NW) * 32 + n;
            if (u == 0 || hasB) {
#pragma unroll
                for (int mt = 0; mt < 2; ++mt)
#pragma unroll
                    for (int qq = 0; qq < 2; ++qq) {
                        float sc = 0.f;
#pragma unroll
                        for (int h = 0; h < 8; ++h) sc += w[mt][qq][h] * fmaxf(u ? cB[mt][8 * qq + h] : cA[mt][8 * qq + h], 0.f);
                        const int ql = 4 * mt + 2 * g + qq;
                        int key = (int)(sc * 4096.f + 32768.5f);
                        key = key < 1 ? 1 : (key > 65535 ? 65535 : key);
                        if (s > t0 + ql) key = 0;
                        KS[ql * SEQ + s] = (unsigned short)key;
                        __hip_atomic_fetch_add((LAS unsigned*)(lds + 131072) + ql * 256 + (key >> 8), 1u, __ATOMIC_RELAXED, __HIP_MEMORY_SCOPE_WORKGROUP);
                    }
            }
        }
}

template <int MODE> __device__ __forceinline__ void indexer_item(KP P, LAS unsigned char* lds, int b, int t0, int wave, int lane) {
    LAS unsigned short* KS = (LAS unsigned short*)lds;
    const GAS f16* QI = (const GAS f16*)(((GAS unsigned char*)P->ws) + WS_QI); const GAS f16* KI = (const GAS f16*)(((GAS unsigned char*)P->ws) + WS_KI); const GAS float* WI = (const GAS float*)(((GAS unsigned char*)P->ws) + WS_WI);
    const int ntiles = (t0 + 8 + 31) >> 5, nkp = ntiles * 32;
    const int n = lane & 31, g = lane >> 5;
    h8 A[2][4]; float w[2][2][8];
#pragma unroll
    for (int mt = 0; mt < 2; ++mt) {
        const int ql = 2 * ((n >> 2) & 1) + (n >> 4), head = 4 * ((n >> 3) & 1) + (n & 3);
        const GAS h8* src = (const GAS h8*)(QI + (size_t)(b * SEQ + t0 + 4 * mt + ql) * 512 + head * 64 + 32 * g);
#pragma unroll
        for (int kk = 0; kk < 4; ++kk) A[mt][kk] = src[kk];
#pragma unroll
        for (int qq = 0; qq < 2; ++qq) { const GAS float* wp = WI + (size_t)(b * SEQ + t0 + 4 * mt + 2 * g + qq) * 8;
            const f32x4 wa = *(const GAS f32x4*)wp, wb = *(const GAS f32x4*)(wp + 4);
#pragma unroll
            for (int h = 0; h < 4; ++h) { w[mt][qq][h] = wa[h]; w[mt][qq][4 + h] = wb[h]; } }
    }
    h8 B0a[4], B0b[4], B1a[4], B1b[4];
    {   const int ta = (wave < ntiles) ? wave : 0, tb = (wave + NW < ntiles) ? wave + NW : ta;
        const GAS h8* pa = (const GAS h8*)(KI + (size_t)(b * SEQ + ta * 32 + n) * 64 + 32 * g);
        const GAS h8* pb = (const GAS h8*)(KI + (size_t)(b * SEQ + tb * 32 + n) * 64 + 32 * g);
#pragma unroll
        for (int kk = 0; kk < 4; ++kk) { B0a[kk] = pa[kk]; B0b[kk] = pb[kk]; } }
    for (int tile = wave; tile < ntiles; tile += 4 * NW) {
        indexer_pair<MODE>(lds, KI, b, t0, ntiles, tile, n, g, A, w, B0a, B0b, B1a, B1b);
        if (tile + 2 * NW < ntiles) indexer_pair<MODE>(lds, KI, b, t0, ntiles, tile + 2 * NW, n, g, A, w, B1a, B1b, B0a, B0b);
    }
    __syncthreads();
    if (MODE & 1) {
        const int t = t0 + wave;
        LAS unsigned short* row = KS + wave * SEQ;
        LAS unsigned* H = (LAS unsigned*)(lds + 131072 + wave * 1024);
        unsigned B1, r1; find_bin(H, lane, 256u, B1, r1);
        *(LAS u32x4*)(H + 4 * lane) = (u32x4){0u, 0u, 0u, 0u};
        for (int s8 = 8 * lane; s8 < nkp; s8 += 512) {
            const u32x4 v = *(const LAS u32x4*)(row + s8);
#pragma unroll
            for (int e = 0; e < 4; ++e) { const unsigned lo = v[e] & 0xffffu, hi = v[e] >> 16;
                if ((lo >> 8) == B1) __hip_atomic_fetch_add(H + (lo & 255u), 1u, __ATOMIC_RELAXED, __HIP_MEMORY_SCOPE_WORKGROUP);
                if ((hi >> 8) == B1) __hip_atomic_fetch_add(H + (hi & 255u), 1u, __ATOMIC_RELAXED, __HIP_MEMORY_SCOPE_WORKGROUP); }
        }
        asm volatile("s_waitcnt lgkmcnt(0)" ::: "memory");
        unsigned B2, r2; find_bin(H, lane, r1, B2, r2);
        *(LAS u32x4*)(H + 4 * lane) = (u32x4){0u, 0u, 0u, 0u};
        const unsigned T = (B1 << 8) | B2;
        LAS unsigned char* mimg = (LAS unsigned char*)(lds + 139264 + wave * 1024);
        *(LAS u32x4*)(mimg + 16 * lane) = (u32x4){0u, 0u, 0u, 0u};
        unsigned eqseen = 0;
        const unsigned long long ltmask = (1ull << lane) - 1ull;
        for (int sb = 0; sb < nkp; sb += 512) {
            const int s8 = sb + 8 * lane;
            u32x4 v = {0u, 0u, 0u, 0u};
            if (s8 < nkp) v = *(const LAS u32x4*)(row + s8);
            unsigned kk[8];
#pragma unroll
            for (int e = 0; e < 4; ++e) { kk[2 * e] = v[e] & 0xffffu; kk[2 * e + 1] = v[e] >> 16; }
            unsigned eqb = 0, gtb = 0;
#pragma unroll
            for (int e = 0; e < 8; ++e) { eqb |= (kk[e] == T) ? (1u << e) : 0u; gtb |= (kk[e] > T) ? (1u << e) : 0u; }
            unsigned takeeq = 0;
            if (__ballot(eqb != 0u)) {
                unsigned lower = 0, tot = 0;
#pragma unroll
                for (int e = 0; e < 8; ++e) { const unsigned long long m = __ballot((eqb >> e) & 1u); lower += (unsigned)__popcll(m & ltmask); tot += (unsigned)__popcll(m); }
#pragma unroll
                for (int e = 0; e < 8; ++e) { const unsigned rk = eqseen + lower + (unsigned)__builtin_popcount(eqb & ((1u << e) - 1u)); if (((eqb >> e) & 1u) && rk < r2) takeeq |= 1u << e; }
                eqseen += tot;
            }
            if (s8 < nkp) mimg[s8 >> 3] = (unsigned char)(gtb | takeeq);
        }
        asm volatile("s_waitcnt lgkmcnt(0)" ::: "memory");
        {   GAS unsigned long long* mo = (GAS unsigned long long*)(((GAS unsigned char*)P->ws) + WS_MASK) + (size_t)b * 128 * SEQ + t;
            const int ntq = 4 * ((t >> 8) + 1);
#pragma unroll
            for (int h2 = 0; h2 < 2; ++h2) { const int tile = lane + 64 * h2;
                if (tile < ntq) { const u32x4 dummy = {0u, 0u, 0u, 0u}; (void)dummy;
                    const unsigned lo = *(const LAS unsigned*)(mimg + 8 * tile), hi = *(const LAS unsigned*)(mimg + 8 * tile + 4);
                    mo[(size_t)tile * SEQ] = (unsigned long long)lo | ((unsigned long long)hi << 32); } }
        }
        asm volatile("s_waitcnt lgkmcnt(0)" ::: "memory");
    }
    __syncthreads();
}

__device__ __forceinline__ void causal_masks(KP P, int b, int t, int lane) {
    if (lane < 4) { const int rel = t - 64 * lane;
        const unsigned long long m = (rel >= 63) ? ~0ull : (rel < 0 ? 0ull : ((1ull << (rel + 1)) - 1ull));
        ((GAS unsigned long long*)(((GAS unsigned char*)P->ws) + WS_MASK))[((size_t)b * 128 + lane) * SEQ + t] = m; }
}
template <int MODE> __device__ __forceinline__ void indexer_phase(KP P, LAS unsigned char* lds, int G, int c, int wave, int lane) {
    *(LAS u32x4*)(lds + 131072 + (wave * 64 + lane) * 16) = (u32x4){0u, 0u, 0u, 0u};
    __syncthreads();
    if (G == 256) {
        for (int rr = 0; rr < 8; ++rr) { const int b = rr >> 2, q = rr & 3;
            const int blk = (q == 0) ? c : (q == 1) ? 511 - c : (q == 2) ? 512 + c : 1023 - c;
            if (8 * blk + 7 >= 256) indexer_item<MODE>(P, lds, b, 8 * blk, wave, lane); else causal_masks(P, b, 8 * blk + wave, lane); }
    } else {
        for (int it = c; it < 2048; it += G) { const int b = it >> 10, blk = it & 1023; if (8 * blk + 7 >= 256) indexer_item<MODE>(P, lds, b, 8 * blk, wave, lane); else causal_masks(P, b, 8 * blk + wave, lane); }
    }
}

__device__ __forceinline__ float dot8(h8 a, h8 b) {
    float r = __builtin_amdgcn_fdot2(__builtin_shufflevector(a, a, 0, 1), __builtin_shufflevector(b, b, 0, 1), 0.f, false);
    r = __builtin_amdgcn_fdot2(__builtin_shufflevector(a, a, 2, 3), __builtin_shufflevector(b, b, 2, 3), r, false);
    r = __builtin_amdgcn_fdot2(__builtin_shufflevector(a, a, 4, 5), __builtin_shufflevector(b, b, 4, 5), r, false);
    r = __builtin_amdgcn_fdot2(__builtin_shufflevector(a, a, 6, 7), __builtin_shufflevector(b, b, 6, 7), r, false);
    return r;
}
__device__ __forceinline__ void attn_phase(KP P, int gw, int NGW, int lane) {
    const GAS f16* Q = (const GAS f16*)(((GAS unsigned char*)P->ws) + WS_Q); const GAS f16* K = (const GAS f16*)(((GAS unsigned char*)P->ws) + WS_K); const GAS f16* V = (const GAS f16*)(((GAS unsigned char*)P->ws) + WS_V);
    GAS f16* ATT = (GAS f16*)(((GAS unsigned char*)P->ws) + WS_ATT); const GAS unsigned short* SEL = (const GAS unsigned short*)(((GAS unsigned char*)P->ws) + WS_SEL);
    const int kslot = lane >> 3, sub = lane & 7;
    for (int tok = gw; tok < TT; tok += NGW) {
        const int t = tok & (SEQ - 1), b = tok >> 13;
        const int nsel = (t + 1 < 256) ? t + 1 : 256; const bool implicit = t < 256;
        const int nit = (nsel + 7) >> 3;
        h8 q[8];
#pragma unroll
        for (int c = 0; c < 8; ++c) q[c] = *(const GAS h8*)(Q + (size_t)tok * 512 + 64 * c + 8 * sub);
        float den[8], acc[8][8];
#pragma unroll
        for (int c = 0; c < 8; ++c) { den[c] = 0.f;
#pragma unroll
            for (int d = 0; d < 8; ++d) acc[c][d] = 0.f; }
        const GAS unsigned short* selp = SEL + (size_t)tok * 256;
        for (int it = 0; it < nit; ++it) {
            const int j = 8 * it + kslot; const bool valid = j < nsel;
            int s = 0;
            if (valid) s = implicit ? j : (int)selp[j];
            const size_t ro = (size_t)(b * SEQ + s) * 512 + 8 * sub;
            h8 kv[8], vv[8];
#pragma unroll
            for (int c = 0; c < 8; ++c) kv[c] = *(const GAS h8*)(K + ro + 64 * c);
#pragma unroll
            for (int c = 0; c < 8; ++c) vv[c] = *(const GAS h8*)(V + ro + 64 * c);
#pragma unroll
            for (int c = 0; c < 8; ++c) {
                float pt = dot8(q[c], kv[c]);
                pt += __shfl_xor(pt, 1); pt += __shfl_xor(pt, 2); pt += __shfl_xor(pt, 4);
                const float p = valid ? __expf(pt) : 0.f;
                den[c] += p;
                const f32x8 vf = __builtin_convertvector(vv[c], f32x8);
#pragma unroll
                for (int d = 0; d < 8; ++d) acc[c][d] += p * vf[d];
            }
        }
#pragma unroll
        for (int c = 0; c < 8; ++c) {
            den[c] += __shfl_xor(den[c], 8); den[c] += __shfl_xor(den[c], 16); den[c] += __shfl_xor(den[c], 32);
#pragma unroll
            for (int d = 0; d < 8; ++d) { float a = acc[c][d]; a += __shfl_xor(a, 8); a += __shfl_xor(a, 16); a += __shfl_xor(a, 32); acc[c][d] = a; }
        }
#pragma unroll
        for (int c = 0; c < 8; ++c) if (kslot == c) {
            const float inv = 1.f / den[c];
            f32x8 o;
#pragma unroll
            for (int d = 0; d < 8; ++d) o[d] = acc[c][d] * inv;
            *(GAS h8*)(ATT + (size_t)tok * 512 + 64 * c + 8 * sub) = __builtin_convertvector(o, h8);
        }
    }
}


__device__ __forceinline__ float dpp_ror8(float x) { return __builtin_bit_cast(float, __builtin_amdgcn_update_dpp(0, __builtin_bit_cast(int, x), 0x128, 0xf, 0xf, false)); }
__device__ __forceinline__ void attn_phase2(KP P, int gw, int NGW, int lane) {
    const GAS f16* Q = (const GAS f16*)(((GAS unsigned char*)P->ws) + WS_Q); const GAS f16* K = (const GAS f16*)(((GAS unsigned char*)P->ws) + WS_K); const GAS f16* V = (const GAS f16*)(((GAS unsigned char*)P->ws) + WS_V);
    GAS f16* ATT = (GAS f16*)(((GAS unsigned char*)P->ws) + WS_ATT); const GAS unsigned short* SEL = (const GAS unsigned short*)(((GAS unsigned char*)P->ws) + WS_SEL);
    const int r = lane & 15, g = lane >> 4, hh = r & 7, half = r >> 3;
    const h8 zero8 = {0, 0, 0, 0, 0, 0, 0, 0};
    for (int tok = gw; tok < TT; tok += NGW) {
        const int t = tok & (SEQ - 1), b = tok >> 13;
        const int nsel = (t + 1 < 256) ? t + 1 : 256; const bool implicit = t < 256;
        const int nit = (nsel + 15) >> 4;
        h8 qf[2];
#pragma unroll
        for (int e = 0; e < 2; ++e) qf[e] = (r < 8) ? *(const GAS h8*)(Q + (size_t)tok * 512 + 64 * r + 32 * e + 8 * g) : zero8;
        const GAS unsigned short* selp = SEL + (size_t)tok * 256;
        const GAS f16* Kb = K + (size_t)b * SEQ * 512 + 8 * g; const GAS f16* Vb = V + (size_t)b * SEQ * 512 + 64 * hh + 32 * half;
        int sr, sv[4];
        if (implicit) { sr = (r < nsel) ? r : 0;
#pragma unroll
            for (int i = 0; i < 4; ++i) sv[i] = (4 * g + i < nsel) ? 4 * g + i : 0; }
        else { sr = selp[r]; const unsigned long long w = *(const GAS unsigned long long*)(selp + 4 * g);
#pragma unroll
            for (int i = 0; i < 4; ++i) sv[i] = (int)((w >> (16 * i)) & 0xffffu); }
        h8 kf[16], vf[4][4];
#pragma unroll
        for (int s = 0; s < 16; ++s) kf[s] = *(const GAS h8*)(Kb + (size_t)sr * 512 + 32 * s);
#pragma unroll
        for (int i = 0; i < 4; ++i)
#pragma unroll
            for (int c = 0; c < 4; ++c) vf[i][c] = *(const GAS h8*)(Vb + (size_t)sv[i] * 512 + 8 * c);
        float acc[32], den = 0.f;
#pragma unroll
        for (int d = 0; d < 32; ++d) acc[d] = 0.f;
        for (int it = 0; it < nit; ++it) {
            const bool more = it + 1 < nit;
            int srn = 0, svn[4] = {0, 0, 0, 0};
            if (more) {
                const int j0 = 16 * (it + 1);
                if (implicit) { srn = (j0 + r < nsel) ? j0 + r : 0;
#pragma unroll
                    for (int i = 0; i < 4; ++i) svn[i] = (j0 + 4 * g + i < nsel) ? j0 + 4 * g + i : 0; }
                else { srn = selp[j0 + r]; const unsigned long long w = *(const GAS unsigned long long*)(selp + j0 + 4 * g);
#pragma unroll
                    for (int i = 0; i < 4; ++i) svn[i] = (int)((w >> (16 * i)) & 0xffffu); }
            }
            f32x4 c = {0.f, 0.f, 0.f, 0.f};
            int rr = r; asm volatile("" : "+v"(rr));
#pragma unroll
            for (int s = 0; s < 16; ++s) { const h8 bq = (rr == (s >> 1)) ? qf[s & 1] : zero8; c = __builtin_amdgcn_mfma_f32_16x16x32_f16(kf[s], bq, c, 0, 0, 0); }
            if (more) {
#pragma unroll
                for (int s = 0; s < 16; ++s) kf[s] = *(const GAS h8*)(Kb + (size_t)srn * 512 + 32 * s);
            }
            float p[4];
#pragma unroll
            for (int i = 0; i < 4; ++i) { const int j = 16 * it + 4 * g + i; float pi = (j < nsel && r < 8) ? __expf(c[i]) : 0.f; den += pi; p[i] = pi + dpp_ror8(pi); }
#pragma unroll
            for (int i = 0; i < 4; ++i)
#pragma unroll
                for (int cc = 0; cc < 4; ++cc)
#pragma unroll
                    for (int e = 0; e < 4; ++e) { const unsigned vw = __builtin_bit_cast(u32x4, vf[i][cc])[e];
                        asm("v_fma_mix_f32 %0, %1, %2, %0 op_sel_hi:[0,1,0]" : "+v"(acc[8 * cc + 2 * e]) : "v"(p[i]), "v"(vw));
                        asm("v_fma_mix_f32 %0, %1, %2, %0 op_sel:[0,1,0] op_sel_hi:[0,1,0]" : "+v"(acc[8 * cc + 2 * e + 1]) : "v"(p[i]), "v"(vw)); }
            if (more) {
#pragma unroll
                for (int i = 0; i < 4; ++i)
#pragma unroll
                    for (int cc = 0; cc < 4; ++cc) vf[i][cc] = *(const GAS h8*)(Vb + (size_t)svn[i] * 512 + 8 * cc);
            }
        }
        den += dpp_ror8(den);
        den += __shfl_xor(den, 16); den += __shfl_xor(den, 32);
        const float inv = 1.f / den;
#pragma unroll
        for (int d = 0; d < 32; ++d) { float a = acc[d]; a += __shfl_xor(a, 16); a += __shfl_xor(a, 32); acc[d] = a * inv; }
#pragma unroll
        for (int cc = 0; cc < 4; ++cc) if (g == cc) {
            f32x8 o;
#pragma unroll
            for (int e = 0; e < 8; ++e) o[e] = acc[8 * cc + e];
            *(GAS h8*)(ATT + (size_t)tok * 512 + 64 * hh + 32 * half + 8 * cc) = __builtin_convertvector(o, h8);
        }
    }
}


template <int L> __device__ __forceinline__ float bcast_row(float x) { return __builtin_bit_cast(float, __builtin_amdgcn_update_dpp(0, __builtin_bit_cast(int, x), 0x150 + L, 0xf, 0xf, false)); }
#define PV_STEP(i, cc) do { const float pa = bcast_row<2 * (cc)>(p[i]), pb = bcast_row<2 * (cc) + 1>(p[i]); const float pp = hi ? pb : pa; \
    _Pragma("unroll") for (int e = 0; e < 4; ++e) { const unsigned vw = __builtin_bit_cast(u32x4, vf[i][cc])[e]; \
        asm("v_fma_mix_f32 %0, %1, %2, %0 op_sel_hi:[0,1,0]" : "+v"(acc[8 * (cc) + 2 * e]) : "v"(pp), "v"(vw)); \
        asm("v_fma_mix_f32 %0, %1, %2, %0 op_sel:[0,1,0] op_sel_hi:[0,1,0]" : "+v"(acc[8 * (cc) + 2 * e + 1]) : "v"(pp), "v"(vw)); } } while (0)
__device__ __forceinline__ void attn_phase3(KP P, LAS unsigned char* lds, int gw, int NGW, int wave, int lane) {
    const GAS f16* Q = (const GAS f16*)(((GAS unsigned char*)P->ws) + WS_Q); const GAS f16* K = (const GAS f16*)(((GAS unsigned char*)P->ws) + WS_K); const GAS f16* V = (const GAS f16*)(((GAS unsigned char*)P->ws) + WS_V);
    GAS f16* ATT = (GAS f16*)(((GAS unsigned char*)P->ws) + WS_ATT); const GAS unsigned short* SEL = (const GAS unsigned short*)(((GAS unsigned char*)P->ws) + WS_SEL);
    const int r = lane & 15, g = lane >> 4; const bool hi = (r >> 3) != 0;
    const h8 zero8 = {0, 0, 0, 0, 0, 0, 0, 0};
    LAS unsigned short* sidx = (LAS unsigned short*)(lds + wave * 512);
    for (int tok = gw; tok < TT; tok += NGW) {
        const int t = tok & (SEQ - 1), b = tok >> 13;
        const int nsel = (t + 1 < 256) ? t + 1 : 256; const bool implicit = t < 256;
        const int nit = (nsel + 15) >> 4;
        const GAS unsigned short* selp = SEL + (size_t)tok * 256;
        {   unsigned long long w;
            if (implicit) { w = 0ull;
#pragma unroll
                for (int k = 0; k < 4; ++k) { const int j = 4 * lane + k; w |= (unsigned long long)((j < nsel) ? j : 0) << (16 * k); } }
            else w = *(const GAS unsigned long long*)(selp + 4 * lane);
            *(LAS unsigned long long*)(sidx + 4 * lane) = w; }
        h8 qf[2];
#pragma unroll
        for (int e = 0; e < 2; ++e) qf[e] = (r < 8) ? *(const GAS h8*)(Q + (size_t)tok * 512 + 64 * r + 32 * e + 8 * g) : zero8;
        const GAS f16* Kb = K + (size_t)b * SEQ * 512 + 8 * g; const GAS f16* Vb = V + (size_t)b * SEQ * 512 + 8 * r;
        int sr = sidx[r]; unsigned long long sw = *(const LAS unsigned long long*)(sidx + 4 * g);
        h8 kf[16], vf[4][4];
#pragma unroll
        for (int s = 0; s < 16; ++s) kf[s] = *(const GAS h8*)(Kb + (size_t)sr * 512 + 32 * s);
#pragma unroll
        for (int i = 0; i < 4; ++i) { const int sv = (int)((sw >> (16 * i)) & 0xffffu);
#pragma unroll
            for (int c = 0; c < 4; ++c) vf[i][c] = *(const GAS h8*)(Vb + (size_t)sv * 512 + 128 * c); }
        float acc[32], den = 0.f;
#pragma unroll
        for (int d = 0; d < 32; ++d) acc[d] = 0.f;
        for (int it = 0; it < nit; ++it) {
            const int itn = (it + 1 < nit) ? it + 1 : 0;
            sr = sidx[16 * itn + r]; sw = *(const LAS unsigned long long*)(sidx + 16 * itn + 4 * g);
            f32x4 c = {0.f, 0.f, 0.f, 0.f};
            int rr = r; asm volatile("" : "+v"(rr));
#pragma unroll
            for (int s = 0; s < 16; ++s) { const h8 bq = (rr == (s >> 1)) ? qf[s & 1] : zero8; c = __builtin_amdgcn_mfma_f32_16x16x32_f16(kf[s], bq, c, 0, 0, 0); }
            __builtin_amdgcn_sched_barrier(0);
#pragma unroll
            for (int s = 0; s < 16; ++s) kf[s] = *(const GAS h8*)(Kb + (size_t)sr * 512 + 32 * s);
            __builtin_amdgcn_sched_barrier(0);
            float p[4];
#pragma unroll
            for (int i = 0; i < 4; ++i) { const int j = 16 * it + 4 * g + i; p[i] = (j < nsel && r < 8) ? __expf(c[i]) : 0.f; den += p[i]; }
#pragma unroll
            for (int i = 0; i < 4; ++i) { PV_STEP(i, 0); PV_STEP(i, 1); PV_STEP(i, 2); PV_STEP(i, 3); }
            __builtin_amdgcn_sched_barrier(0);
#pragma unroll
            for (int i = 0; i < 4; ++i) { const int sv = (int)((sw >> (16 * i)) & 0xffffu);
#pragma unroll
                for (int cc = 0; cc < 4; ++cc) vf[i][cc] = *(const GAS h8*)(Vb + (size_t)sv * 512 + 128 * cc); }
        }
        den += __shfl_xor(den, 16); den += __shfl_xor(den, 32);
        float dinv[4];
        { const float d0 = bcast_row<0>(den), d1 = bcast_row<1>(den), d2 = bcast_row<2>(den), d3 = bcast_row<3>(den), d4 = bcast_row<4>(den), d5 = bcast_row<5>(den), d6 = bcast_row<6>(den), d7 = bcast_row<7>(den);
          dinv[0] = 1.f / (hi ? d1 : d0); dinv[1] = 1.f / (hi ? d3 : d2); dinv[2] = 1.f / (hi ? d5 : d4); dinv[3] = 1.f / (hi ? d7 : d6); }
#pragma unroll
        for (int d = 0; d < 32; ++d) { float a = acc[d]; a += __shfl_xor(a, 16); a += __shfl_xor(a, 32); acc[d] = a * dinv[d >> 3]; }
#pragma unroll
        for (int cc = 0; cc < 4; ++cc) if (g == cc) {
            f32x8 o;
#pragma unroll
            for (int e = 0; e < 8; ++e) o[e] = acc[8 * cc + e];
            *(GAS h8*)(ATT + (size_t)tok * 512 + 128 * cc + 8 * r) = __builtin_convertvector(o, h8);
        }
    }
}


template <int CTRL> __device__ __forceinline__ float dpp_add(float x) { return x + __builtin_bit_cast(float, __builtin_amdgcn_update_dpp(0, __builtin_bit_cast(int, x), CTRL, 0xf, 0xf, false)); }
__device__ __forceinline__ void attn_phase4(KP P, LAS unsigned char* lds, int gw, int NGW, int wave, int lane) {
    const GAS f16* Q = (const GAS f16*)(((GAS unsigned char*)P->ws) + WS_Q); const GAS f16* K = (const GAS f16*)(((GAS unsigned char*)P->ws) + WS_K); const GAS f16* V = (const GAS f16*)(((GAS unsigned char*)P->ws) + WS_V);
    GAS f16* ATT = (GAS f16*)(((GAS unsigned char*)P->ws) + WS_ATT); const GAS unsigned short* SEL = (const GAS unsigned short*)(((GAS unsigned char*)P->ws) + WS_SEL);
    const int kslot = lane >> 3, sub = lane & 7;
    LAS unsigned short* sidx = (LAS unsigned short*)(lds + wave * 512);
    for (int tok = gw; tok < TT; tok += NGW) {
        const int t = tok & (SEQ - 1), b = tok >> 13;
        const int nsel = (t + 1 < 256) ? t + 1 : 256; const bool implicit = t < 256;
        const int nit = (nsel + 7) >> 3;
        const GAS unsigned short* selp = SEL + (size_t)tok * 256;
        {   unsigned long long w;
            if (implicit) { w = 0ull;
#pragma unroll
                for (int k = 0; k < 4; ++k) { const int j = 4 * lane + k; w |= (unsigned long long)((j < nsel) ? j : 0) << (16 * k); } }
            else w = *(const GAS unsigned long long*)(selp + 4 * lane);
            asm volatile("" ::: "memory");
#pragma unroll
            for (int k = 0; k < 4; ++k) sidx[4 * lane + k] = (unsigned short)((w >> (16 * k)) & 0xffffull);
            asm volatile("s_waitcnt lgkmcnt(0)" ::: "memory"); }
        h8 q[8];
#pragma unroll
        for (int c = 0; c < 8; ++c) q[c] = *(const GAS h8*)(Q + (size_t)tok * 512 + 64 * c + 8 * sub);
        float den[8], acc[8][8];
#pragma unroll
        for (int c = 0; c < 8; ++c) { den[c] = 0.f;
#pragma unroll
            for (int d = 0; d < 8; ++d) acc[c][d] = 0.f; }
        const GAS f16* Kb = K + (size_t)b * SEQ * 512 + 8 * sub; const GAS f16* Vb = V + (size_t)b * SEQ * 512 + 8 * sub;
        int s = sidx[kslot];
        h8 kv[8], vv[8];
#pragma unroll
        for (int c = 0; c < 8; ++c) kv[c] = *(const GAS h8*)(Kb + (size_t)s * 512 + 64 * c);
#pragma unroll
        for (int c = 0; c < 8; ++c) vv[c] = *(const GAS h8*)(Vb + (size_t)s * 512 + 64 * c);
        for (int it = 0; it < nit; ++it) {
            const int itn = (it + 1 < nit) ? it + 1 : 0;
            s = sidx[8 * itn + kslot];
            const bool valid = (8 * it + kslot) < nsel;
            float p[8];
#pragma unroll
            for (int c = 0; c < 8; ++c) { float pt = dot8(q[c], kv[c]); pt = dpp_add<0xB1>(pt); pt = dpp_add<0x4E>(pt); pt = dpp_add<0x141>(pt); p[c] = pt; }
            __builtin_amdgcn_sched_barrier(0);
#pragma unroll
            for (int c = 0; c < 8; ++c) kv[c] = *(const GAS h8*)(Kb + (size_t)s * 512 + 64 * c);
            __builtin_amdgcn_sched_barrier(0);
#pragma unroll
            for (int c = 0; c < 8; ++c) {
                const float pe = valid ? __expf(p[c]) : 0.f;
                den[c] += pe;
#pragma unroll
                for (int e = 0; e < 4; ++e) { const unsigned vw = __builtin_bit_cast(u32x4, vv[c])[e];
                    asm("v_fma_mix_f32 %0, %1, %2, %0 op_sel_hi:[0,1,0]" : "+v"(acc[c][2 * e]) : "v"(pe), "v"(vw));
                    asm("v_fma_mix_f32 %0, %1, %2, %0 op_sel:[0,1,0] op_sel_hi:[0,1,0]" : "+v"(acc[c][2 * e + 1]) : "v"(pe), "v"(vw)); }
            }
            __builtin_amdgcn_sched_barrier(0);
#pragma unroll
            for (int c = 0; c < 8; ++c) vv[c] = *(const GAS h8*)(Vb + (size_t)s * 512 + 64 * c);
        }
#pragma unroll
        for (int c = 0; c < 8; ++c) {
            den[c] += __shfl_xor(den[c], 8); den[c] += __shfl_xor(den[c], 16); den[c] += __shfl_xor(den[c], 32);
#pragma unroll
            for (int d = 0; d < 8; ++d) { float a = acc[c][d]; a += __shfl_xor(a, 8); a += __shfl_xor(a, 16); a += __shfl_xor(a, 32); acc[c][d] = a; }
        }
#pragma unroll
        for (int c = 0; c < 8; ++c) if (kslot == c) {
            const float inv = 1.f / den[c];
            f32x8 o;
#pragma unroll
            for (int d = 0; d < 8; ++d) o[d] = acc[c][d] * inv;
            *(GAS h8*)(ATT + (size_t)tok * 512 + 64 * c + 8 * sub) = __builtin_convertvector(o, h8);
        }
    }
}

#define XB_TMO      128
#define XB_XCNT(j)  (256  + 64 * (j))
#define XB_XSUB(j)  (1280 + 64 * (j))
#define XB_XGEN(j)  (2304 + 64 * (j))
#define XB_TOP      3328
#define XB_TOPGEN   3392
#define XCD_BAR_WORDS 3456
#define XB_SPIN_CAP (1u << 18)

__device__ __forceinline__ unsigned xb_ld(unsigned* p)              { return __hip_atomic_load(p, __ATOMIC_RELAXED, __HIP_MEMORY_SCOPE_AGENT); }
__device__ __forceinline__ unsigned xb_add(unsigned* p, unsigned v) { return __hip_atomic_fetch_add(p, v, __ATOMIC_RELAXED, __HIP_MEMORY_SCOPE_AGENT); }
__device__ __forceinline__ unsigned xb_xcc_id() { return (unsigned)__builtin_amdgcn_s_getreg((3 << 11) | 20) & 0xFu; }
#define XB_SPIN(cond, bar) do { unsigned _sp = 0; while (cond) { __builtin_amdgcn_s_sleep(1); \
    if ((++_sp & 255u) == 0u) { if (xb_ld(&(bar)[XB_TMO])) break; if (_sp > XB_SPIN_CAP) { atomicAdd(&(bar)[XB_TMO], 1u); break; } } } } while (0)

struct XcdBarrier {
    unsigned* bar; unsigned x;
    volatile LAS unsigned* st;
};

__device__ __forceinline__ XcdBarrier xcd_barrier_post(unsigned* bar, volatile LAS unsigned* st) {
    XcdBarrier b; b.bar = bar; b.x = xb_xcc_id(); b.st = st;
    if (threadIdx.x == 0) (void)xb_add(&bar[XB_XCNT(b.x)], 1u);
    return b;
}
__device__ __forceinline__ void xcd_barrier_complete(unsigned* bar, unsigned x, unsigned& nloc, unsigned& nx) {
    const unsigned G = gridDim.x * gridDim.y * gridDim.z;
    unsigned sum, cnt, mine, sp = 0u;
    for (;;) {
        sum = 0u; cnt = 0u; mine = 0u;
#pragma unroll
        for (unsigned j = 0; j < 16; ++j) { const unsigned c = xb_ld(&bar[XB_XCNT(j)]); sum += c; cnt += (c > 0u) ? 1u : 0u; mine = (j == x) ? c : mine; }
        if (sum == G) break;
        __builtin_amdgcn_s_sleep(1);
        if ((++sp & 255u) == 0u) { if (xb_ld(&bar[XB_TMO])) break; if (sp > XB_SPIN_CAP) { atomicAdd(&bar[XB_TMO], 1u); break; } }
    }
    nloc = mine > 0u ? mine : 1u; nx = cnt > 0u ? cnt : 1u;
}

__device__ __forceinline__ void xcd_barrier(const XcdBarrier& b) {
    asm volatile("s_waitcnt vmcnt(0)" ::: "memory");
    __syncthreads();
    if (threadIdx.x == 0) {
        unsigned* bar = b.bar;
        __builtin_amdgcn_s_waitcnt(0);
        unsigned nloc = b.st[0], nx = b.st[1];
        if (nloc == 0u) { xcd_barrier_complete(bar, b.x, nloc, nx); b.st[0] = nloc; b.st[1] = nx; }
        const unsigned old = xb_add(&bar[XB_XSUB(b.x)], 1u);
        const unsigned gen = old / nloc;
        if (old + 1u == (gen + 1u) * nloc) {
            __builtin_amdgcn_fence(__ATOMIC_RELEASE, "agent");
            asm volatile("s_waitcnt vmcnt(0)" ::: "memory");
            const unsigned og = xb_add(&bar[XB_TOP], 1u);
            const unsigned tg = og / nx;
            if (og + 1u == (tg + 1u) * nx) xb_add(&bar[XB_TOPGEN], 1u);
            else XB_SPIN(xb_ld(&bar[XB_TOPGEN]) == tg, bar);
            __builtin_amdgcn_fence(__ATOMIC_ACQUIRE, "agent");
            xb_add(&bar[XB_XGEN(b.x)], 1u);
            asm volatile("s_waitcnt vmcnt(0)" ::: "memory");
        } else {
            XB_SPIN(xb_ld(&bar[XB_XGEN(b.x)]) == gen, bar);
            __builtin_amdgcn_fence(__ATOMIC_ACQUIRE, "agent");
            asm volatile("s_waitcnt vmcnt(0)" ::: "memory");
        }
    }
    __syncthreads();
}


#define GEMM_PHASE(EPI, epi, Aoff, Boff, NN, KK) do { int kk_ = (KK); asm volatile("" : "+s"(kk_)); pg8::Gemm g{(const pg8::bf16_t*)(ws + (Aoff)), (const pg8::bf16_t*)(ws + (Boff)), TT, (NN), kk_}; \
    pg8::StaticOrder S; S.init(TT, (NN), G, (int)blockIdx.x); pg8::gemm_phase<EPI, pg8::StaticOrder, true, true>(lds, g, S, epi, wave); } while (0)

__device__ __forceinline__ KP opaque_params() { KP p = (KP)__builtin_amdgcn_kernarg_segment_ptr(); asm volatile("" : "+s"(p)); return p; }
__global__ void __launch_bounds__(512) mega_fwd(Params P_) {
    extern __shared__ __attribute__((aligned(16))) unsigned char lds_raw[];
    LAS unsigned char* lds = (LAS unsigned char*)lds_raw;
    cg::grid_group grid = cg::this_grid();
    if (threadIdx.x < 16) ((LAS unsigned*)(lds + LDS_BYTES - 64))[threadIdx.x] = 0u;
    __syncthreads();
    const XcdBarrier xbar = xcd_barrier_post((unsigned*)(P_.ws + 65536), (volatile LAS unsigned*)(lds + LDS_BYTES - 64));
    const int wave = __builtin_amdgcn_readfirstlane(threadIdx.x >> 6);
    const int G = gridDim.x, bx = blockIdx.x;
    const int gw = bx * NW + wave, NGW = G * NW;
    GAS unsigned char* ws = (GAS unsigned char*)P_.ws;
#define LANEID(l) int l; asm volatile("v_mbcnt_lo_u32_b32 %0, -1, 0\n\tv_mbcnt_hi_u32_b32 %0, -1, %0" : "=v"(l))
#define PP (opaque_params())
    GAS f16* const GAp = (GAS f16*)(ws + WS_GA); GAS f16* const GCp = (GAS f16*)(ws + WS_GC);
    GAS float* const SS1 = (GAS float*)(ws + WS_SS1); GAS float* const SS2 = (GAS float*)(ws + WS_SS2);

    { LANEID(lane); phase0<3>(PP, lds, gw, NGW, wave, lane); }
    if (gridDim.x == 0x7fffffffu) grid.sync();
    xcd_barrier(xbar);
    {   LAS float* gtab = (LAS float*)(lds + 131072);
        if (threadIdx.x < 128) gtab[threadIdx.x] = (threadIdx.x < 64) ? ((const GAS float*)PP->in[4])[threadIdx.x] : ((const GAS float*)PP->in[5])[threadIdx.x - 64];
        __syncthreads();
        EpiG1 E{ws, gtab}; GEMM_PHASE(EpiG1, E, WS_H, WS_W1T, N1, 1024); }
    if (G == 256) { if (bx >= 64) { LANEID(lane); phase0<4>(PP, lds, (bx - 64) * NW + wave, 192 * NW, wave, lane); } }
    else { LANEID(lane); phase0<4>(PP, lds, gw, NGW, wave, lane); }
    xcd_barrier(xbar);
    { LANEID(lane); conv_phase(PP, lds, gw, NGW, wave * 64 + lane, lane); }
    { LANEID(lane); indexer_phase<1>(PP, lds, G, bx, wave, lane); }
    xcd_barrier(xbar);
    { const attn_body::AttnTensors AT{(const attn_body::bf16*)(P_.ws + WS_Q), (const attn_body::bf16*)(P_.ws + WS_K), (const attn_body::bf16*)(P_.ws + WS_V), (attn_body::bf16*)(P_.ws + WS_ATT), (const unsigned long long*)(P_.ws + WS_MASK)};
      const attn_body::StaticOrder S(G, bx);
      bool safe;
      {   LANEID(lane); float gq = __builtin_fabsf(((const GAS float*)PP->in[4])[lane]), gk = __builtin_fabsf(((const GAS float*)PP->in[5])[lane]);
#pragma unroll
          for (int o = 1; o < 64; o <<= 1) { gq = fmaxf(gq, __shfl_xor(gq, o)); gk = fmaxf(gk, __shfl_xor(gk, o)); }
          safe = __builtin_amdgcn_readfirstlane((11.6f * gq * gk < 60.f) ? 1 : 0) != 0; }
      attn_body::attn_phase<attn_body::StaticOrder>((char*)lds_raw, AT, S, safe); }
    xcd_barrier(xbar);
    { EpiN<0> E{(GAS f16*)(ws + WS_MERGED), GAp, nullptr, nullptr, nullptr, nullptr, nullptr}; GEMM_PHASE(EpiN<0>, E, WS_ATT, WS_WAOT, 1024, 512); }
    { EpiN<1> E{(GAS f16*)(ws + WS_MERGED), GCp, nullptr, nullptr, nullptr, nullptr, nullptr}; GEMM_PHASE(EpiN<1>, E, WS_CONV, WS_WCOT, 1024, 512); }
    xcd_barrier(xbar);
    { EpiN<2> E{(GAS f16*)(ws + WS_X1H), nullptr, ((const GAS float*)PP->in[0]), nullptr, SS1, nullptr, nullptr}; GEMM_PHASE(EpiN<2>, E, WS_MERGED, WS_WOUTT, 1024, 1024); }
    xcd_barrier(xbar);
    {   LAS float* tab = (LAS float*)(lds + 131072); LAS int* pml = (LAS int*)(lds + 131072 + 16384);
        {   pg8::StaticOrder S0; S0.init(TT, NGU, G, (int)blockIdx.x); pg8::Unit u0; LANEID(lane);
            const int t = wave * 64 + lane;
            for (int i = 0; i < 16; ++i) {
                const bool ok = S0.next(i, u0);
                if (t == 0) pml[i] = ok ? u0.pm : -1;
                if (ok && t < 256) { const GAS f32x4* sp = (const GAS f32x4*)(SS1 + (size_t)(u0.pm * 256 + t) * 16); const f32x4 s = (sp[0] + sp[1]) + (sp[2] + sp[3]);
                    tab[i * 256 + t] = __builtin_amdgcn_rsqf(((s[0] + s[1]) + (s[2] + s[3])) * (1.f / 1024.f) + EPS); }
            }
            __syncthreads(); }
        EpiGU E{(GAS f16*)(ws + WS_ACT), tab, pml}; GEMM_PHASE(EpiGU, E, WS_X1H, WS_WGUT, NGU, 1024); }
    if (G == 256 && bx >= 128) {
        EpiN<3> E{(GAS f16*)(ws + WS_TMP), nullptr, nullptr, nullptr, nullptr, nullptr, nullptr};
        int kk_ = 256; asm volatile("" : "+s"(kk_));
        pg8::Gemm g{(const pg8::bf16_t*)(ws + WS_P16), (const pg8::bf16_t*)(ws + WS_WPPT), TT, 1024, kk_};
        pg8::StaticOrder S; S.init(TT, 1024, 128, (int)blockIdx.x - 128);
        pg8::gemm_phase<EpiN<3>, pg8::StaticOrder, true, true>(lds, g, S, E, wave);
    }
    xcd_barrier(xbar);
    { EpiN<5> E{(GAS f16*)(ws + WS_X2H), nullptr, nullptr, nullptr, SS2, nullptr, (const GAS f16*)(ws + WS_X1H)}; GEMM_PHASE(EpiN<5>, E, WS_ACT, WS_WDT, 1024, DFF); }
    xcd_barrier(xbar);
    if (G != 256) { EpiN<3> E{(GAS f16*)(ws + WS_TMP), nullptr, nullptr, nullptr, nullptr, nullptr, nullptr}; GEMM_PHASE(EpiN<3>, E, WS_P16, WS_WPPT, 1024, 256); }
    { EpiN<4> E{nullptr, (const GAS f16*)(ws + WS_TMP), nullptr, ((GAS float*)PP->out), nullptr, SS2, (const GAS f16*)(ws + WS_X2H)}; GEMM_PHASE(EpiN<4>, E, WS_X2H, WS_WPGT, 1024, 1024); }
}

extern "C" void kernel_launch(void* const* d_in, const int* in_sizes, int n_in, void* d_out, int out_size, void* d_ws, size_t ws_size, hipStream_t stream) {
    static int grid = 0;
    if (grid == 0) {
        if (n_in != 20 || out_size != TT * DM || ws_size < WS_END) { fprintf(stderr, "kernel_launch: unexpected problem shape (n_in %d out %d ws %zu)\n", n_in, out_size, ws_size); grid = -1; return; }
        int dev = 0, cus = 0, per_cu = 0;
        hipGetDevice(&dev); hipDeviceGetAttribute(&cus, hipDeviceAttributeMultiprocessorCount, dev);
        if (hipFuncSetAttribute((const void*)mega_fwd, hipFuncAttributeMaxDynamicSharedMemorySize, LDS_BYTES) != hipSuccess) { fprintf(stderr, "kernel_launch: hipFuncSetAttribute failed\n"); grid = -1; return; }
        if (hipOccupancyMaxActiveBlocksPerMultiprocessor(&per_cu, (const void*)mega_fwd, 512, LDS_BYTES) != hipSuccess || per_cu < 1) { fprintf(stderr, "kernel_launch: occupancy query says %d\n", per_cu); per_cu = 1; }
        (void)hipGetLastError();
        grid = cus;
    }
    if (grid < 0) return;
    if (hipMemsetAsync(d_ws, 0, 1u << 20, stream) != hipSuccess) { fprintf(stderr, "kernel_launch: memset failed\n"); return; }
    Params p{};
    for (int i = 0; i < 20; ++i) p.in[i] = (const float*)d_in[i];
    p.out = (float*)d_out; p.ws = (unsigned char*)d_ws;
    void* args[] = {&p};
    hipError_t e = hipLaunchCooperativeKernel((const void*)mega_fwd, dim3(grid), dim3(512), args, LDS_BYTES, stream);
    if (e != hipSuccess) fprintf(stderr, "cooperative launch failed: %s (grid %d)\n", hipGetErrorString(e), grid);
}
```

```cpp
#include <hip/hip_runtime.h>
#include <hip/hip_cooperative_groups.h>
#include <hip/hip_bf16.h>
#include <cmath>
#include <cstdio>
#include <cstdint>
namespace cg = cooperative_groups;
namespace pg8 {
#define PG8_LAS __attribute__((address_space(3)))
typedef unsigned short bf16_t;
typedef _Float16 bf16x8 __attribute__((ext_vector_type(8)));
typedef float f32x4 __attribute__((ext_vector_type(4)));
typedef unsigned u32x4 __attribute__((ext_vector_type(4)));
constexpr int BM = 256, BK = 64, HALF = 128, HTB = HALF * BK * 2  , STAGE_BYTES = 8 * HTB, NXCD = 8, WGM = 8;

__host__ __device__ __forceinline__ int lds_byte(int r, int c) { const int st = (r >> 4) * 2 + (c >> 5), rr = r & 15, cc = c & 31, ob = rr * 64 + cc * 2; return st * 1024 + (ob ^ (((ob >> 9) & 1) << 5)); }
__host__ __device__ __forceinline__ void stage_rc(int b, int& R, int& C) { const int st = b / 1024, sb = b % 1024, swz = sb ^ (((sb >> 9) & 1) << 5); R = (st >> 1) * 16 + swz / 64; C = (st & 1) * 32 + (swz % 64) / 2; }
__host__ __device__ __forceinline__ int perm32(int rho) { const int n = rho >> 4, i = rho & 15; return 8 * (i >> 2) + 4 * n + (i & 3); }

struct Unit { int pm, pn; };
struct Gemm { const bf16_t* A; const bf16_t* Bt; int M, N, K; };

struct StaticOrder {
    int nM, nN, nwg, G, c;
    __host__ __device__ void init(int M, int N, int G_, int c_) { nM = M / BM; nN = N / BM; nwg = nM * nN; G = G_; c = c_; }
    __host__ __device__ bool next(int i, Unit& u) const {
        const long L = (long)i * G + c; if (L >= nwg) return false;
        int wgid = (int)L; { const int q = nwg / NXCD, r = nwg % NXCD, xcd = wgid % NXCD, off = wgid / NXCD; wgid = (xcd < r ? xcd * (q + 1) : r * (q + 1) + (xcd - r) * q) + off; }
        const int nig = WGM * nN, gid = wgid / nig, fm = gid * WGM, gsz = (nM - fm) < WGM ? (nM - fm) : WGM;
        u.pm = fm + ((wgid % nig) % gsz); u.pn = (wgid % nig) / gsz; return true;
    }
    __device__ __forceinline__ void a_ready(const Unit&) const {}
    __device__ __forceinline__ void done(const Unit&) const {}
};

template <class Epi, class Sched, bool ALIGN_EPI = false, bool SP2 = false>
__device__ __forceinline__ void gemm_phase(PG8_LAS unsigned char* lds, const Gemm g, const Sched& S, const Epi& E, const int wid_in) {
    int lane; asm volatile("v_mbcnt_lo_u32_b32 %0, -1, 0\n\tv_mbcnt_hi_u32_b32 %0, -1, %0" : "=v"(lane)); const int wid = wid_in, tid = wid * 64 + lane, wr = wid >> 2, wc = wid & 3, fr = lane & 15, fq = lane >> 4;
    const int K = g.K, nt = K / BK;
    unsigned voffA[2], voffB[2];
#pragma unroll
    for (int i = 0; i < 2; ++i) { int R, C; stage_rc(tid * 16 + i * 8192, R, C); const int Rb = Epi::PERM ? ((R & ~31) + perm32(R & 31)) : R;
        voffA[i] = (unsigned)(R * K + C) * 2u; voffB[i] = (unsigned)(Rb * K + C) * 2u; }
    const size_t kstep = (size_t)(BK * 2);
    const size_t hstep = (size_t)HALF * K * 2;
    const size_t tstep = 2 * hstep;
    const unsigned ldsw = (unsigned)wid * 1024u;
    const int aoff = lds_byte(wr * 64 + fr, fq * 8), boff = lds_byte(wc * 32 + fr, fq * 8);
#define PG8_SA(b, h) (((b) * 2 + (h)) * HTB)
#define PG8_SB(b, h) ((4 + (b) * 2 + (h)) * HTB)
#define PG8_STAGE(bufoff, gbase, voff) do { _Pragma("unroll") for (int _i = 0; _i < 2; ++_i) \
        __builtin_amdgcn_global_load_lds((const unsigned*)((const char*)(gbase) + (voff)[_i]), (PG8_LAS unsigned*)(lds + (bufoff) + ldsw + _i * 8192), 16, 0, 0); } while (0)
#define PG8_LDA(dst, b, h) do { _Pragma("unroll") for (int m = 0; m < 4; ++m) _Pragma("unroll") for (int k = 0; k < 2; ++k) dst[m][k] = *(const PG8_LAS bf16x8*)(lds + PG8_SA(b, h) + aoff + m * 2048 + k * 1024); } while (0)
#define PG8_LDB(dst, b, h) do { _Pragma("unroll") for (int n = 0; n < 2; ++n) _Pragma("unroll") for (int k = 0; k < 2; ++k) dst[n][k] = *(const PG8_LAS bf16x8*)(lds + PG8_SB(b, h) + boff + n * 2048 + k * 1024); } while (0)
#define PG8_MMA(ai, bj, At, Bt) do { __builtin_amdgcn_s_setprio(1); _Pragma("unroll") for (int m = 0; m < 4; ++m) _Pragma("unroll") for (int n = 0; n < 2; ++n) _Pragma("unroll") for (int k = 0; k < 2; ++k) \
        acc[ai][bj][m][n] = __builtin_amdgcn_mfma_f32_16x16x32_f16(Bt[n][k], At[m][k], acc[ai][bj][m][n], 0, 0, 0); __builtin_amdgcn_s_setprio(0); } while (0)
#define PG8_WAIT_V(n) asm volatile("s_waitcnt vmcnt(" #n ")" ::: "memory")
#define PG8_WAIT_L(n) asm volatile("s_waitcnt lgkmcnt(" #n ")" ::: "memory")
#define PG8_BAR __builtin_amdgcn_s_barrier()
#define PG8_SCHED __builtin_amdgcn_sched_barrier(0)
    Unit cur, nxt; int ui = 0;
    if (!S.next(0, cur)) return;
    f32x4 acc[2][2][4][2];
#pragma unroll
    for (int a = 0; a < 2; ++a)
#pragma unroll
        for (int b = 0; b < 2; ++b)
#pragma unroll
            for (int m = 0; m < 4; ++m)
#pragma unroll
                for (int n = 0; n < 2; ++n) acc[a][b][m][n] = (f32x4){0.f, 0.f, 0.f, 0.f};
    bf16x8 At[4][2], B0[2][2], B1[2][2];
    const char* cA = (const char*)g.A + (size_t)cur.pm * tstep; const char* cB = (const char*)g.Bt + (size_t)cur.pn * tstep;
    S.a_ready(cur);
    if constexpr (SP2) {
        PG8_STAGE(PG8_SB(0, 0), cB, voffB); PG8_STAGE(PG8_SB(0, 1), cB + hstep, voffB); PG8_STAGE(PG8_SA(0, 0), cA, voffA); PG8_STAGE(PG8_SA(0, 1), cA + hstep, voffA);
        if (wr == 1) PG8_BAR;
        PG8_WAIT_V(2); PG8_BAR;
        PG8_STAGE(PG8_SB(1, 0), cB + kstep, voffB); PG8_STAGE(PG8_SA(1, 0), cA + kstep, voffA); PG8_STAGE(PG8_SB(1, 1), cB + hstep + kstep, voffB);
        PG8_WAIT_V(6); PG8_BAR;
    } else {
        PG8_STAGE(PG8_SB(0, 0), cB, voffB); PG8_STAGE(PG8_SA(0, 0), cA, voffA); PG8_STAGE(PG8_SB(0, 1), cB + hstep, voffB); PG8_STAGE(PG8_SA(0, 1), cA + hstep, voffA);
        if (wr == 1) PG8_BAR;
        PG8_WAIT_V(4); PG8_BAR;
        PG8_STAGE(PG8_SB(1, 0), cB + kstep, voffB); PG8_STAGE(PG8_SA(1, 0), cA + kstep, voffA); PG8_STAGE(PG8_SB(1, 1), cB + hstep + kstep, voffB);
        PG8_WAIT_V(6); PG8_BAR;
    }
    for (;;) {
        const bool has_next = S.next(ui + 1, nxt);
        const char* nA = has_next ? (const char*)g.A + (size_t)nxt.pm * tstep : cA; const char* nB = has_next ? (const char*)g.Bt + (size_t)nxt.pn * tstep : cB;
        for (int t = 0; t < nt; t += 2) {
            const bool last = (t == nt - 2);
            const char* a1 = cA + (size_t)(t + 1) * kstep;
            const char* a2 = last ? nA : cA + (size_t)(t + 2) * kstep; const char* b2 = last ? nB : cB + (size_t)(t + 2) * kstep;
            const char* a3 = a2 + kstep; const char* b3 = b2 + kstep;
            if (last && has_next) S.a_ready(nxt);
            if constexpr (SP2) {
            PG8_LDB(B0, 0, 0); PG8_LDB(B1, 0, 1); PG8_SCHED; PG8_LDA(At, 0, 0); PG8_STAGE(PG8_SA(1, 1), a1 + hstep, voffA);
            PG8_WAIT_V(8); PG8_WAIT_L(0); PG8_BAR; PG8_MMA(0, 0, At, B0); PG8_MMA(0, 1, At, B1); PG8_BAR; PG8_SCHED;
            PG8_LDA(At, 0, 1); PG8_STAGE(PG8_SB(0, 0), b2, voffB); PG8_STAGE(PG8_SB(0, 1), b2 + hstep, voffB); PG8_STAGE(PG8_SA(0, 0), a2, voffA);
            PG8_WAIT_V(8); PG8_WAIT_L(0); PG8_BAR; PG8_MMA(1, 0, At, B0); PG8_MMA(1, 1, At, B1); PG8_BAR; PG8_SCHED;
            PG8_LDB(B0, 1, 0); PG8_LDB(B1, 1, 1); PG8_SCHED; PG8_LDA(At, 1, 0); PG8_STAGE(PG8_SA(0, 1), a2 + hstep, voffA);
            PG8_WAIT_V(8); PG8_WAIT_L(0); PG8_BAR; PG8_MMA(0, 0, At, B0); PG8_MMA(0, 1, At, B1); PG8_BAR; PG8_SCHED;
            PG8_LDA(At, 1, 1); PG8_STAGE(PG8_SB(1, 0), b3, voffB); PG8_STAGE(PG8_SB(1, 1), b3 + hstep, voffB); PG8_STAGE(PG8_SA(1, 0), a3, voffA);
            PG8_WAIT_V(8); PG8_WAIT_L(0); PG8_BAR; PG8_MMA(1, 0, At, B0); PG8_MMA(1, 1, At, B1); PG8_BAR; PG8_SCHED;
            } else {
            PG8_LDB(B0, 0, 0); PG8_SCHED; PG8_LDA(At, 0, 0); PG8_STAGE(PG8_SA(1, 1), a1 + hstep, voffA);
            PG8_WAIT_L(8); PG8_BAR; PG8_WAIT_L(0); PG8_MMA(0, 0, At, B0); PG8_BAR; PG8_SCHED;
            PG8_LDB(B1, 0, 1); PG8_STAGE(PG8_SB(0, 0), b2, voffB);
            PG8_BAR; PG8_WAIT_L(0); PG8_MMA(0, 1, At, B1); PG8_BAR;
            PG8_LDA(At, 0, 1); PG8_STAGE(PG8_SA(0, 0), a2, voffA);
            PG8_BAR; PG8_WAIT_L(0); PG8_MMA(1, 0, At, B0); PG8_BAR; PG8_SCHED;
            PG8_STAGE(PG8_SB(0, 1), b2 + hstep, voffB);
            PG8_WAIT_V(6); PG8_BAR; PG8_MMA(1, 1, At, B1); PG8_BAR;
            PG8_LDB(B0, 1, 0); PG8_SCHED; PG8_LDA(At, 1, 0); PG8_STAGE(PG8_SA(0, 1), a2 + hstep, voffA);
            PG8_WAIT_L(8); PG8_BAR; PG8_WAIT_L(0); PG8_MMA(0, 0, At, B0); PG8_BAR; PG8_SCHED;
            PG8_LDB(B1, 1, 1); PG8_STAGE(PG8_SB(1, 0), b3, voffB);
            PG8_BAR; PG8_WAIT_L(0); PG8_MMA(0, 1, At, B1); PG8_BAR;
            PG8_LDA(At, 1, 1); PG8_STAGE(PG8_SA(1, 0), a3, voffA);
            PG8_BAR; PG8_WAIT_L(0); PG8_MMA(1, 0, At, B0); PG8_BAR; PG8_SCHED;
            PG8_STAGE(PG8_SB(1, 1), b3 + hstep, voffB);
            PG8_WAIT_V(6); PG8_BAR; PG8_MMA(1, 1, At, B1); PG8_BAR;
            }
        }
        if constexpr (ALIGN_EPI) { if (wr == 0) PG8_BAR; }
        if constexpr (!Epi::AFTER_DRAIN) { E(acc, cur, wr, wc, fr, fq); S.done(cur); }
        if (!has_next) break;
#pragma unroll
        for (int a = 0; a < 2; ++a)
#pragma unroll
            for (int b = 0; b < 2; ++b)
#pragma unroll
                for (int m = 0; m < 4; ++m)
#pragma unroll
                    for (int n = 0; n < 2; ++n) acc[a][b][m][n] = (f32x4){0.f, 0.f, 0.f, 0.f};
        cur = nxt; cA = nA; cB = nB; ++ui;
        if constexpr (ALIGN_EPI) { if (wr == 1) PG8_BAR; }
    }
    PG8_WAIT_V(0);
    if constexpr (!ALIGN_EPI) { if (wr == 0) PG8_BAR; }
    PG8_BAR;
    if constexpr (Epi::AFTER_DRAIN) { E.fused(acc, cur, wr, wc, fr, fq, lds, wid, lane); S.done(cur); }
#undef PG8_SA
#undef PG8_SB
#undef PG8_STAGE
#undef PG8_LDA
#undef PG8_LDB
#undef PG8_MMA
#undef PG8_WAIT_V
#undef PG8_WAIT_L
#undef PG8_BAR
#undef PG8_SCHED
}
}
namespace attn_body {
using bf16=__hip_bfloat16;
using bf16x8=__attribute__((ext_vector_type(8)))short;
using s16x4=__attribute__((ext_vector_type(4)))short;
using f32x16=__attribute__((ext_vector_type(16)))float;
using u32x4=__attribute__((ext_vector_type(4)))unsigned;
constexpr int BATCH=2,NHEAD=8,SEQ=8192,D=64,DM=NHEAD*D;
constexpr int NW=8,QBLK=32,QB=QBLK*NW,KVBLK=64,NQB=SEQ/QB;
constexpr int ATTN_PITCH=DM, ATTN_UNIT_ROWS=QB;
__device__ __forceinline__ int crow(int r,int hi){return (r&3)+8*(r>>2)+4*hi;}
#define SBAR() __builtin_amdgcn_sched_barrier(0)
__device__ __forceinline__ void cmask(f32x16&p0,f32x16&p1,int jb,int qrel,int hi){
  const float NEG=-INFINITY; int kb=64*jb+4*hi;
  #pragma unroll
  for(int r=0;r<16;++r){int kv=kb+(r&3)+8*(r>>2); if(kv>qrel)p0[r]=NEG; if(kv+32>qrel)p1[r]=NEG;}
}

__device__ __forceinline__ void smask(f32x16&p0,f32x16&p1,unsigned long long w,int hi,float mh){
  const unsigned lo=((unsigned)w)>>(4*hi), hh=((unsigned)(w>>32))>>(4*hi);
  if(__builtin_expect(__any(mh!=0.f),0)){
    #pragma unroll
    for(int r=0;r<16;++r){p0[r]-=mh;p1[r]-=mh;} }
  #pragma unroll
  for(int r=0;r<16;++r){ const unsigned bit=(unsigned)((r&3)+8*(r>>2));
    const unsigned t0=(unsigned)__builtin_amdgcn_sbfe((int)lo,bit,1u), t1=(unsigned)__builtin_amdgcn_sbfe((int)hh,bit,1u);
    float x0=p0[r],x1=p1[r];
    asm("v_bfi_b32 %0, %1, %0, %2":"+v"(x0):"v"(t0),"s"(0xFF800000u));
    asm("v_bfi_b32 %0, %1, %0, %2":"+v"(x1):"v"(t1),"s"(0xFF800000u));
    p0[r]=x0; p1[r]=x1; }
}
constexpr int NSLOT=3, SLOTB=8192;
constexpr int LDS_K=0, LDS_V=NSLOT*SLOTB, LDS_WS=2*NSLOT*SLOTB, LDS_OST=LDS_WS+NW*64*4, LDS_BYTES=LDS_OST+NW*4096;
constexpr float C2=0.125f*1.4426950408889634f;
__device__ __forceinline__ void glds16(const void*gsrc,unsigned lds_dst){unsigned keep;
  asm volatile("s_mov_b32 %0, m0\n\ts_mov_b32 m0, %2\n\ts_nop 0\n\tglobal_load_lds_dwordx4 %1, off\n\ts_mov_b32 m0, %0":"=&s"(keep):"v"(gsrc),"s"(lds_dst):"memory");}
__device__ __forceinline__ float max3f(float a,float b,float c){float r;asm("v_max3_f32 %0, %1, %2, %3":"=v"(r):"v"(a),"v"(b),"v"(c));return r;}
__device__ __forceinline__ float max2f(float a,float b){float r;asm("v_max_f32_e32 %0, %1, %2":"=v"(r):"v"(a),"v"(b));return r;}
__device__ __forceinline__ float fadd_s(float a,float b){float r;asm("v_add_f32_e32 %0, %1, %2":"=v"(r):"v"(a),"v"(b));return r;}
__device__ __forceinline__ float fsub_s(float a,float b){float r;asm("v_sub_f32_e32 %0, %1, %2":"=v"(r):"v"(a),"v"(b));return r;}
typedef float f32x2_t __attribute__((ext_vector_type(2))); typedef __bf16 bf16x2_t __attribute__((ext_vector_type(2)));
__device__ __forceinline__ unsigned cvtpk_s(float lo,float hi){f32x2_t v={lo,hi};bf16x2_t b=__builtin_convertvector(v,bf16x2_t);return __builtin_bit_cast(unsigned,b);}
#define WAIT_BAR(N) asm volatile("s_waitcnt vmcnt(" #N ") lgkmcnt(0)\n\ts_barrier":::"memory")

__device__ __forceinline__ void qkt(f32x16&p0,f32x16&p1,const char*Kslot,const bf16x8*qr,int r32,int hi){ const f32x16 negm=f32x16{};
  const char*kb=Kslot+hi*1024+r32*16;
  #pragma unroll
  for(int d0=0;d0<4;++d0){
    const bf16x8 b0=*reinterpret_cast<const bf16x8*>(kb+d0*2048);
    const bf16x8 b1=*reinterpret_cast<const bf16x8*>(kb+d0*2048+512);
    if(d0==0){p0=__builtin_amdgcn_mfma_f32_32x32x16_bf16(b0,qr[0],negm,0,0,0);p1=__builtin_amdgcn_mfma_f32_32x32x16_bf16(b1,qr[0],negm,0,0,0);}
    else{p0=__builtin_amdgcn_mfma_f32_32x32x16_bf16(b0,qr[d0],p0,0,0,0);p1=__builtin_amdgcn_mfma_f32_32x32x16_bf16(b1,qr[d0],p1,0,0,0);}}
}
typedef __attribute__((address_space(3))) const char* lds_cptr;
typedef short v4i16_t __attribute__((ext_vector_type(4)));
__device__ __forceinline__ void kload8(bf16x8*kf,lds_cptr kp){
  kf[0]=*(const __attribute__((address_space(3))) bf16x8*)(kp);      kf[1]=*(const __attribute__((address_space(3))) bf16x8*)(kp+512);
  kf[2]=*(const __attribute__((address_space(3))) bf16x8*)(kp+2048); kf[3]=*(const __attribute__((address_space(3))) bf16x8*)(kp+2560);
  kf[4]=*(const __attribute__((address_space(3))) bf16x8*)(kp+4096); kf[5]=*(const __attribute__((address_space(3))) bf16x8*)(kp+4608);
  kf[6]=*(const __attribute__((address_space(3))) bf16x8*)(kp+6144); kf[7]=*(const __attribute__((address_space(3))) bf16x8*)(kp+6656);
}
__device__ __forceinline__ void kload2(bf16x8*kf,lds_cptr kp,int j){ kf[2*j]=*(const __attribute__((address_space(3))) bf16x8*)(kp+j*2048); kf[2*j+1]=*(const __attribute__((address_space(3))) bf16x8*)(kp+j*2048+512); }
__device__ __forceinline__ s16x4 vtr(lds_cptr p){ return __builtin_bit_cast(s16x4,__builtin_amdgcn_ds_read_tr16_b64_v4i16((__attribute__((address_space(3))) v4i16_t*)p)); }
__device__ __forceinline__ float rowmax(const f32x16&p0,const f32x16&p1){
  float a=max3f(p0[0],p0[1],p1[0]),b=max3f(p0[2],p0[3],p1[1]);a=max3f(a,p1[2],p1[3]);
  #pragma unroll
  for(int r=4;r<16;r+=4){a=max3f(a,p0[r],p0[r+1]);b=max3f(b,p0[r+2],p0[r+3]);a=max3f(a,p1[r],p1[r+1]);b=max3f(b,p1[r+2],p1[r+3]);}
  const float m=max2f(a,b);
  auto rr=__builtin_amdgcn_permlane32_swap(__float_as_uint(m),__float_as_uint(m),false,false);
  return max2f(__uint_as_float(rr[0]),__uint_as_float(rr[1]));
}
__device__ __forceinline__ void pv(f32x16*o,int vb,bf16x8 pa0,bf16x8 pa1,bf16x8 pa2,bf16x8 pa3){
  #pragma unroll
  for(int d0=0;d0<2;++d0){s16x4 lo[4],hi[4];
    #pragma unroll
    for(int ks=0;ks<4;++ks){
      asm volatile("ds_read_b64_tr_b16 %0,%1 offset:%c2":"=&v"(lo[ks]):"v"(vb),"i"(d0*4096+ks*1024):"memory");
      asm volatile("ds_read_b64_tr_b16 %0,%1 offset:%c2":"=&v"(hi[ks]):"v"(vb),"i"(d0*4096+ks*1024+512):"memory");}
    asm volatile("s_waitcnt lgkmcnt(0)":::"memory");SBAR();
    #define PK(k) (bf16x8){lo[k][0],lo[k][1],lo[k][2],lo[k][3],hi[k][0],hi[k][1],hi[k][2],hi[k][3]}
    o[d0]=__builtin_amdgcn_mfma_f32_32x32x16_bf16(pa0,PK(0),o[d0],0,0,0);
    o[d0]=__builtin_amdgcn_mfma_f32_32x32x16_bf16(pa1,PK(1),o[d0],0,0,0);
    o[d0]=__builtin_amdgcn_mfma_f32_32x32x16_bf16(pa2,PK(2),o[d0],0,0,0);
    o[d0]=__builtin_amdgcn_mfma_f32_32x32x16_bf16(pa3,PK(3),o[d0],0,0,0);
    #undef PK
  }
}

#ifndef ATTN_STORE16
#define ATTN_STORE16(p,v) (*(u32x4*)(p)=(v))
#endif
template<int THRL> __device__ __forceinline__ void attn_unit(int b,int h,int qb,const bf16*Q,const bf16*__restrict__ K,const bf16*__restrict__ V,bf16*O,const unsigned long long*MT,char*shm){
  const int tid=threadIdx.x,lane=tid&63,r32=lane&31,hi=lane>>5; const int wid=__builtin_amdgcn_readfirstlane(tid>>6);
  const long rowbase=(long)b*SEQ; const int q0=qb*QB;
  const bf16*Qw=Q+(rowbase+q0+wid*QBLK)*DM+h*D;
  const bf16*Kh=K+rowbase*DM+h*D,*Vh=V+rowbase*DM+h*D;
  const unsigned lds0=(unsigned)(uintptr_t)shm;
  float*wsf=(float*)(shm+LDS_WS)+wid*64;
  const bf16*ksrc=Kh+(long)lane*DM+wid*8;
  const bf16*vsrc=Vh+(long)(16*(wid&3)+(lane>>2))*DM+(wid>>2)*32+(lane&3)*8;
  const unsigned kdst=lds0+LDS_K+wid*1024, vdst=lds0+LDS_V+wid*1024;
  #define DMA_K(t,slot) glds16(ksrc+(long)(t)*KVBLK*DM,(unsigned)__builtin_amdgcn_readfirstlane(kdst+(slot)))
  #define DMA_V(t,slot) glds16(vsrc+(long)(t)*KVBLK*DM,(unsigned)__builtin_amdgcn_readfirstlane(vdst+(slot)))
  const int vb0=(int)(lds0+LDS_V)+((lane>>4)&1)*32+(lane&3)*8+(4*hi+((lane&15)>>2))*64;
  const char*Kbase=shm+LDS_K; bf16x8 kf[8];
  const lds_cptr shm3=(lds_cptr)shm; const lds_cptr kp0=shm3+LDS_K+hi*1024+r32*16; const lds_cptr vp0=shm3+LDS_V+((lane>>4)&1)*32+(lane&3)*8+(4*hi+((lane&15)>>2))*64;
  const int NT=(q0+QB)/KVBLK;
  const unsigned long long*mrow=MT+((long)b*128)*SEQ+q0+wid*QBLK;
  unsigned long long mkA,mkB;
  #define MLOAD(var,t) asm volatile("global_load_dwordx2 %0, %1, %2":"=v"(var):"v"(r32*8),"s"(mrow+(long)(t)*SEQ):"memory")
  #define SMASK(P0,P1,var) do{ asm volatile("":"+v"(var)); smask(P0,P1,var,hi,mhat); }while(0)
  MLOAD(mkA,0);
  DMA_K(0,0);DMA_V(0,0);DMA_K(1,SLOTB);
  bf16x8 qr[4];
  #pragma unroll
  for(int d0=0;d0<4;++d0)qr[d0]=*reinterpret_cast<const bf16x8*>(&Qw[(long)r32*DM+d0*16+hi*8]);
  float mhat=0.f,l_reg=0.f;f32x16 o[2];o[0]=f32x16{};o[1]=f32x16{};
  const int qrel=wid*QBLK+r32;
  bool resc=false;
  #define START(P0,P1) do{ float rm=0.f; if constexpr(THRL<1000){ rm=rowmax(P0,P1); } resc=false; \
    { const float dl=(THRL<1000&&rm>(float)THRL)?rm:0.f; mhat=fadd_s(mhat,dl); \
      _Pragma("unroll") for(int r=0;r<16;++r){P0[r]=fsub_s(P0[r],dl);P1[r]=fsub_s(P1[r],dl);} } \
    _Pragma("unroll") for(int r=0;r<16;++r)P0[r]=__builtin_amdgcn_exp2f(P0[r]); }while(0)
  #define RESC() do{ if(resc){ asm volatile("s_waitcnt lgkmcnt(0)":::"memory"); \
      _Pragma("unroll") for(int d_=0;d_<2;++d_) _Pragma("unroll") for(int r=0;r<16;++r)o[d_][r]*=wsf[crow(r,hi)]; } }while(0)
  f32x16 pA0,pA1,pB0,pB1;
  int sl_prev=0,sl_cur=0,sl_next=SLOTB;
  #define ROT() do{sl_prev=sl_cur;sl_cur=sl_next;sl_next=(sl_next==(NSLOT-1)*SLOTB)?0:sl_next+SLOTB;}while(0)
  DMA_K(2,2*SLOTB);
  WAIT_BAR(3);
  qkt(pA0,pA1,Kbase,qr,r32,hi);asm volatile("s_nop 15\n\ts_nop 7":"+v"(pA0),"+v"(pA1));SMASK(pA0,pA1,mkA);
  START(pA0,pA1);
  _Pragma("unroll") for(int r=0;r<16;++r)pA1[r]=__builtin_amdgcn_exp2f(pA1[r]);
  WAIT_BAR(0);
  MLOAD(mkB,1);
  DMA_K(3,0);DMA_V(1,SLOTB);
  ROT();
  kload8(kf,kp0+sl_cur);
  WAIT_BAR(2);
  s16x4 vlo[8],vhi[8]; u32x4 pw0,pw1,pw2,pw3;
  #define PKW(P,B) cvtpk_s(P[B],P[B+1])
  #define PAF(k) __builtin_bit_cast(bf16x8,pw##k)
  #define VFR(i) (bf16x8){vlo[i][0],vlo[i][1],vlo[i][2],vlo[i][3],vhi[i][0],vhi[i][1],vhi[i][2],vhi[i][3]}
  #define PIN(x) asm volatile("":"+v"(x))
  #define MX3(a,b,c) __builtin_fmaxf(__builtin_fmaxf((a),(b)),(c))
  #define GAPA(MF,A0,A1,A2,A3,W0,W1,PW) do{ MF; sacc+=A0; sacc+=A1; sacc+=A2; sacc+=A3; PIN(sacc); W0; W1; PIN(PW); SBAR(); }while(0)
  #define EX(v) __builtin_amdgcn_exp2f(v)
  #define GAPB(MF,X,B) do{ MF; X[B]=EX(X[B]); X[B+1]=EX(X[B+1]); X[B+2]=EX(X[B+2]); X[B+3]=EX(X[B+3]); PIN(X); SBAR(); }while(0)
  #define VRD(i) do{ vlo[i]=vtr(vp_+(((i)>>2)*4096+((i)&3)*1024)); vhi[i]=vtr(vp_+(((i)>>2)*4096+((i)&3)*1024+512)); }while(0)
  #define KRD(G,j) do{ if(G){ kload2(kf,kp0+sl_next,j); SBAR(); } }while(0)
  #define STEP(C0,C1,P0,P1,t,GK,GV,GL,MKC,MKN) do{ SBAR(); \
    const lds_cptr vp_=vp0+sl_prev; \
    VRD(0); SBAR(); float sacc=(P0[0]+P0[1]); \
    GAPA(C0=__builtin_amdgcn_mfma_f32_32x32x16_bf16(kf[0],qr[0],f32x16{},0,0,0), P0[2],P0[3],P0[4],P0[5],     pw0[0]=PKW(P0,0), pw0[1]=PKW(P0,2), pw0); \
    VRD(4); SBAR(); GAPA(C1=__builtin_amdgcn_mfma_f32_32x32x16_bf16(kf[1],qr[0],f32x16{},0,0,0), P0[6],P0[7],P0[8],P0[9],     pw0[2]=PKW(P0,4), pw0[3]=PKW(P0,6), pw0); \
    VRD(1); SBAR(); GAPA(C0=__builtin_amdgcn_mfma_f32_32x32x16_bf16(kf[2],qr[1],C0,0,0,0),   P0[10],P0[11],P0[12],P0[13], pw1[0]=PKW(P0,8), pw1[1]=PKW(P0,10), pw1); \
    VRD(5); SBAR(); GAPA(C1=__builtin_amdgcn_mfma_f32_32x32x16_bf16(kf[3],qr[1],C1,0,0,0),   P0[14],P0[15],P1[0],P1[1],   pw1[2]=PKW(P0,12),pw1[3]=PKW(P0,14), pw1); \
    VRD(2); SBAR(); GAPA(C0=__builtin_amdgcn_mfma_f32_32x32x16_bf16(kf[4],qr[2],C0,0,0,0),   P1[2],P1[3],P1[4],P1[5],     pw2[0]=PKW(P1,0), pw2[1]=PKW(P1,2), pw2); \
    VRD(6); SBAR(); GAPA(C1=__builtin_amdgcn_mfma_f32_32x32x16_bf16(kf[5],qr[2],C1,0,0,0),   P1[6],P1[7],P1[8],P1[9],     pw2[2]=PKW(P1,4), pw2[3]=PKW(P1,6), pw2); \
    VRD(3); SBAR(); GAPA(C0=__builtin_amdgcn_mfma_f32_32x32x16_bf16(kf[6],qr[3],C0,0,0,0),   P1[10],P1[11],P1[12],P1[13], pw3[0]=PKW(P1,8), pw3[1]=PKW(P1,10), pw3); \
    VRD(7); SBAR(); GAPA(C1=__builtin_amdgcn_mfma_f32_32x32x16_bf16(kf[7],qr[3],C1,0,0,0),   P1[14],P1[15],0.f,0.f,       pw3[2]=PKW(P1,12),pw3[3]=PKW(P1,14), pw3); \
    l_reg+=sacc; \
    if((t)+1<NT){MLOAD(MKN,(t)+1);} if(GK){DMA_K((t)+3,sl_cur);} if(GV){DMA_V((t)+1,sl_next);} \
    SMASK(C0,C1,MKC); \
    resc=false; if constexpr(THRL<1000){ float a=MX3(C0[0],C0[1],C1[0]),b=MX3(C0[2],C0[3],C1[1]); a=MX3(a,C1[2],C1[3]); \
      _Pragma("unroll") for(int r=4;r<16;r+=4){a=MX3(a,C0[r],C0[r+1]);b=MX3(b,C0[r+2],C0[r+3]);a=MX3(a,C1[r],C1[r+1]);b=MX3(b,C1[r+2],C1[r+3]);} \
      float rm=__builtin_fmaxf(a,b); { auto rr=__builtin_amdgcn_permlane32_swap(__float_as_uint(rm),__float_as_uint(rm),false,false); rm=__builtin_fmaxf(__uint_as_float(rr[0]),__uint_as_float(rr[1])); } \
      if(__builtin_expect(__any(rm>(float)THRL),0)){ const float dl=__builtin_fmaxf(rm,0.f); mhat+=dl; \
        _Pragma("unroll") for(int r=0;r<16;++r){C0[r]-=dl;C1[r]-=dl;} \
        const float f=__builtin_amdgcn_exp2f(-dl); l_reg*=f; if(hi==0)wsf[r32]=f; resc=true; } } \
    SBAR(); \
    GAPB(o[0]=__builtin_amdgcn_mfma_f32_32x32x16_bf16(PAF(0),VFR(0),o[0],0,0,0), C0,0); \
    GAPB(o[1]=__builtin_amdgcn_mfma_f32_32x32x16_bf16(PAF(0),VFR(4),o[1],0,0,0), C0,4); \
    KRD(GL,0); GAPB(o[0]=__builtin_amdgcn_mfma_f32_32x32x16_bf16(PAF(1),VFR(1),o[0],0,0,0), C0,8); \
    KRD(GL,1); GAPB(o[1]=__builtin_amdgcn_mfma_f32_32x32x16_bf16(PAF(1),VFR(5),o[1],0,0,0), C0,12); \
    KRD(GL,2); GAPB(o[0]=__builtin_amdgcn_mfma_f32_32x32x16_bf16(PAF(2),VFR(2),o[0],0,0,0), C1,0); \
    KRD(GL,3); GAPB(o[1]=__builtin_amdgcn_mfma_f32_32x32x16_bf16(PAF(2),VFR(6),o[1],0,0,0), C1,4); \
    GAPB(o[0]=__builtin_amdgcn_mfma_f32_32x32x16_bf16(PAF(3),VFR(3),o[0],0,0,0), C1,8); \
    GAPB(o[1]=__builtin_amdgcn_mfma_f32_32x32x16_bf16(PAF(3),VFR(7),o[1],0,0,0), C1,12); \
    }while(0)
  int t=1;
  for(;t+5<NT;t+=2){
    STEP(pB0,pB1,pA0,pA1,t,true,true,true,mkB,mkA);     WAIT_BAR(2); RESC(); ROT();
    STEP(pA0,pA1,pB0,pB1,t+1,true,true,true,mkA,mkB);   WAIT_BAR(2); RESC(); ROT();
  }
  #define ENDW(tt) do{ if((tt)+3<NT){WAIT_BAR(2);} else if((tt)+2<NT){WAIT_BAR(1);} else {WAIT_BAR(0);} }while(0)
  for(;t+1<NT;t+=2){
    STEP(pB0,pB1,pA0,pA1,t,(t+3<NT),(t+1<NT),(t+1<NT),mkB,mkA);       ENDW(t);   RESC(); ROT();
    STEP(pA0,pA1,pB0,pB1,t+1,(t+4<NT),(t+2<NT),(t+2<NT),mkA,mkB);     ENDW(t+1); RESC(); ROT();
  }
  STEP(pB0,pB1,pA0,pA1,NT-1,false,false,false,mkB,mkA); RESC();
  { float sacc=pB0[0]+pB0[1]; _Pragma("unroll") for(int r=2;r<16;++r)sacc+=pB0[r]; _Pragma("unroll") for(int r=0;r<16;++r)sacc+=pB1[r]; l_reg+=sacc;
    pw0=(u32x4){PKW(pB0,0),PKW(pB0,2),PKW(pB0,4),PKW(pB0,6)};pw1=(u32x4){PKW(pB0,8),PKW(pB0,10),PKW(pB0,12),PKW(pB0,14)};pw2=(u32x4){PKW(pB1,0),PKW(pB1,2),PKW(pB1,4),PKW(pB1,6)};pw3=(u32x4){PKW(pB1,8),PKW(pB1,10),PKW(pB1,12),PKW(pB1,14)};
    SBAR(); pv(o,vb0+sl_cur,PAF(0),PAF(1),PAF(2),PAF(3)); }
  #undef PKW
  #undef PAF
  #undef VFR
  #undef PIN
  #undef MX3
  #undef GAPA
  #undef GAPB
  #undef EX
  #undef VRD
  #undef KRD
  #undef STEP
  #undef ENDW
  {auto rr=__builtin_amdgcn_permlane32_swap(__float_as_uint(l_reg),__float_as_uint(l_reg),false,false);l_reg=__uint_as_float(rr[0])+__uint_as_float(rr[1]);}
  if(hi==0)wsf[32+r32]=l_reg;asm volatile("s_waitcnt lgkmcnt(0)":::"memory");
  float rli[16];
  #pragma unroll
  for(int r=0;r<16;++r)rli[r]=__builtin_amdgcn_rcpf(wsf[32+crow(r,hi)]);
  bf16*Ow=O+(rowbase+q0+wid*QBLK)*DM+h*D;
  { bf16*stg=(bf16*)(shm+LDS_OST)+wid*2048;
    #pragma unroll
    for(int r=0;r<16;++r){const int orow=crow(r,hi);
      #pragma unroll
      for(int d0=0;d0<2;++d0)((_Float16*)stg)[orow*64+d0*32+r32]=(_Float16)(o[d0][r]*rli[r]);}
    asm volatile("s_waitcnt lgkmcnt(0)":::"memory");
    #pragma unroll
    for(int i=0;i<4;++i){const int row=i*8+(lane>>3),ch=lane&7; const u32x4 v=*(const u32x4*)(stg+row*64+ch*8); ATTN_STORE16(Ow+(long)row*DM+ch*8,v);} }
  asm volatile("s_waitcnt lgkmcnt(0)\n\ts_barrier":::"memory");
  #undef DMA_K
  #undef DMA_V
  #undef MLOAD
  #undef SMASK
  #undef START
  #undef RESC
  #undef ROT
}
constexpr int ATTN_LDS_BYTES=LDS_BYTES;
struct AttnTensors { const bf16* Q; const bf16* K; const bf16* V; bf16* O; const unsigned long long* MT; };
struct AttnUnit { int bh; int qb; };
struct StaticOrder {
  int vcu,grid,blk;
  __device__ __forceinline__ explicit StaticOrder(int grid_,int block):vcu((block%8)*(grid_/8)+block/8),grid(grid_),blk(block){}
  __device__ __forceinline__ bool next(int i,AttnUnit&u)const{
    if(grid!=256){ const int k=i*grid+blk; if(k>=16*NQB)return false; u.bh=k/NQB; u.qb=NQB-1-(k%NQB); return true; }
    if(i>=2)return false; const int s=vcu&15; u.bh=vcu>>4; u.qb=(i==0)?s:31-s; return true; }
  __device__ __forceinline__ void a_ready(const AttnUnit&)const{}
  __device__ __forceinline__ void done(const AttnUnit&)const{}
};
template<class Sched,int THRL=64> __device__ __forceinline__ void attn_phase(char*lds,const AttnTensors&T,const Sched&S,bool safe){
  AttnUnit u;
  for(int i=0;S.next(i,u);++i){ S.a_ready(u); if(safe) attn_unit<1000>(u.bh/NHEAD,u.bh%NHEAD,u.qb,T.Q,T.K,T.V,T.O,T.MT,lds); else attn_unit<THRL>(u.bh/NHEAD,u.bh%NHEAD,u.qb,T.Q,T.K,T.V,T.O,T.MT,lds); S.done(u); }
}
#undef SBAR
#undef WAIT_BAR
}


#define LAS __attribute__((address_space(3)))
#define GAS __attribute__((address_space(1)))
typedef _Float16 f16;
typedef _Float16 h2 __attribute__((ext_vector_type(2)));
typedef _Float16 h8 __attribute__((ext_vector_type(8)));
typedef float f32x4 __attribute__((ext_vector_type(4)));
typedef float f32x8 __attribute__((ext_vector_type(8)));
typedef float f32x16 __attribute__((ext_vector_type(16)));
typedef unsigned u32x4 __attribute__((ext_vector_type(4)));

constexpr int TT = 16384, SEQ = 8192, DM = 1024, INW = 5192, DFF = 2816, NW = 8;
constexpr float EPS = 1e-6f;
constexpr size_t MiB = 1u << 20;
constexpr size_t WS_W1T = 2 * MiB, WS_WAOT = 13 * MiB, WS_WCOT = 14 * MiB, WS_WOUTT = 15 * MiB, WS_WGUT = 17 * MiB, WS_WDT = 28 * MiB, WS_WPGT = 34 * MiB, WS_WPPT = 36 * MiB;
constexpr size_t WS_SS1 = 37 * MiB, WS_SS2 = 38 * MiB;
constexpr size_t WS_MASK = 56 * MiB;
constexpr size_t WS_H = 40 * MiB, WS_CONV = 40 * MiB, WS_X2H = 40 * MiB;
constexpr size_t WS_Q = 72 * MiB, WS_K = 88 * MiB, WS_MERGED = 72 * MiB, WS_TMP = 72 * MiB;
constexpr size_t WS_V = 104 * MiB, WS_QI = 120 * MiB, WS_X1H = 104 * MiB;
constexpr size_t WS_KI = 136 * MiB, WS_WI = 138 * MiB, WS_GLU = 140 * MiB, WS_GA = 156 * MiB, WS_GC = 188 * MiB, WS_SEL = 220 * MiB, WS_ACT = 136 * MiB;
constexpr size_t WS_ATT = 228 * MiB, WS_P16 = 244 * MiB, WS_END = 252 * MiB;
constexpr int N1 = 21 * 256, NGU = 22 * 256;
constexpr int LDS_BYTES = 148480;

struct Params { const float* in[20]; float* out; unsigned char* ws; };
typedef const __attribute__((address_space(4))) Params* KP;

__device__ __forceinline__ h8 pack8(f32x4 a, f32x4 b) {
    f32x8 v = {a[0], a[1], a[2], a[3], b[0], b[1], b[2], b[3]};
    return __builtin_convertvector(v, h8);
}
typedef __bf16 bf2v __attribute__((ext_vector_type(2)));
typedef float f32x2v __attribute__((ext_vector_type(2)));
__device__ __forceinline__ unsigned pkbf(float lo, float hi) { f32x2v v = {lo, hi}; return __builtin_bit_cast(unsigned, __builtin_convertvector(v, bf2v)); }
__device__ __forceinline__ u32x4 pack8_bf16(f32x4 a, f32x4 b) { return (u32x4){pkbf(a[0], a[1]), pkbf(a[2], a[3]), pkbf(b[0], b[1]), pkbf(b[2], b[3])}; }
__device__ __forceinline__ float sigm(float x) { return __builtin_amdgcn_rcpf(1.f + __expf(-x)); }
__device__ __forceinline__ f32x4 sigm4(f32x4 x) { f32x4 r; r[0] = sigm(x[0]); r[1] = sigm(x[1]); r[2] = sigm(x[2]); r[3] = sigm(x[3]); return r; }
__device__ __forceinline__ float wave_sum(float v) {
#pragma unroll
    for (int o = 1; o < 64; o <<= 1) v += __shfl_xor(v, o);
    return v;
}
__device__ __forceinline__ float sq4(f32x4 x) { return (x[0] * x[0] + x[1] * x[1]) + (x[2] * x[2] + x[3] * x[3]); }

struct EpiG1 {
    static constexpr bool PERM = true, AFTER_DRAIN = false;
    GAS unsigned char* wsb; const LAS float* gtab;
    __device__ __forceinline__ void operator()(const f32x4 (&acc)[2][2][4][2], const pg8::Unit& u, int wr, int wc, int fr, int fq) const {
        GAS f16* const Q = (GAS f16*)(wsb + WS_Q); GAS f16* const K = (GAS f16*)(wsb + WS_K); GAS f16* const V = (GAS f16*)(wsb + WS_V); GAS f16* const QI = (GAS f16*)(wsb + WS_QI); GAS f16* const KI = (GAS f16*)(wsb + WS_KI);
        GAS f16* const GLU = (GAS f16*)(wsb + WS_GLU); GAS f16* const GA = (GAS f16*)(wsb + WS_GA); GAS f16* const GC = (GAS f16*)(wsb + WS_GC); GAS float* const WI = (GAS float*)(wsb + WS_WI);
        const int row0 = u.pm * 256 + wr * 64 + fr;
        const int pn = u.pn;
        if (pn < 4) {
            const bool isq = pn < 2; const LAS float* g = gtab + (isq ? 0 : 64); GAS f16* O = isq ? Q : K;
            const int head = 4 * (pn & 1) + wc; const float sc = isq ? 0.125f * 1.4426950408889634f : 1.f;
            f32x4 gv[2][2];
#pragma unroll
            for (int bj = 0; bj < 2; ++bj)
#pragma unroll
                for (int n = 0; n < 2; ++n) gv[bj][n] = *(const LAS f32x4*)(g + 32 * bj + 8 * fq + 4 * n);
#pragma unroll
            for (int ai = 0; ai < 2; ++ai)
#pragma unroll
                for (int m = 0; m < 4; ++m) {
                    float ss = (sq4(acc[ai][0][m][0]) + sq4(acc[ai][0][m][1])) + (sq4(acc[ai][1][m][0]) + sq4(acc[ai][1][m][1]));
                    ss += __shfl_xor(ss, 16); ss += __shfl_xor(ss, 32);
                    const float rinv = __builtin_amdgcn_rsqf(ss * (1.f / 64.f) + EPS) * sc;
                    GAS f16* rowp = O + (size_t)(row0 + ai * 128 + m * 16) * 512 + head * 64 + 8 * fq;
#pragma unroll
                    for (int bj = 0; bj < 2; ++bj) *(GAS u32x4*)(rowp + 32 * bj) = pack8_bf16(acc[ai][bj][m][0] * rinv * gv[bj][0], acc[ai][bj][m][1] * rinv * gv[bj][1]);
                }
        } else if (pn < 8) {
            GAS f16* O = (pn < 6) ? V : QI; const float sc = (pn < 6) ? 1.f : 0.125f;
            const int col0 = 256 * (pn & 1) + 32 * wc + 8 * fq;
#pragma unroll
            for (int ai = 0; ai < 2; ++ai)
#pragma unroll
                for (int m = 0; m < 4; ++m) { GAS f16* rowp = O + (size_t)(row0 + ai * 128 + m * 16) * 512 + col0;
#pragma unroll
                    for (int bj = 0; bj < 2; ++bj) { if (pn < 6) *(GAS u32x4*)(rowp + 128 * bj) = pack8_bf16(acc[ai][bj][m][0], acc[ai][bj][m][1]); else *(GAS h8*)(rowp + 128 * bj) = pack8(acc[ai][bj][m][0] * sc, acc[ai][bj][m][1] * sc); } }
        } else if (pn == 8) {
#pragma unroll
            for (int ai = 0; ai < 2; ++ai)
#pragma unroll
                for (int m = 0; m < 4; ++m) { const size_t row = (size_t)(row0 + ai * 128 + m * 16);
                    if (wc < 2) *(GAS h8*)(KI + row * 64 + 32 * wc + 8 * fq) = pack8(acc[ai][0][m][0], acc[ai][0][m][1]);
                    else if (wc == 2 && fq == 0) { *(GAS f32x4*)(WI + row * 8) = acc[ai][0][m][0] * 0.35355339059f; *(GAS f32x4*)(WI + row * 8 + 4) = acc[ai][0][m][1] * 0.35355339059f; } }
        } else if (pn < 13) {
            const int col0 = 128 * (pn - 9) + 32 * wc + 8 * fq;
#pragma unroll
            for (int ai = 0; ai < 2; ++ai)
#pragma unroll
                for (int m = 0; m < 4; ++m)
                    *(GAS h8*)(GLU + (size_t)(row0 + ai * 128 + m * 16) * 512 + col0) = pack8(acc[ai][0][m][0] * sigm4(acc[ai][1][m][0]), acc[ai][0][m][1] * sigm4(acc[ai][1][m][1]));
        } else {
            GAS f16* O = (pn < 17) ? GA : GC; const int col0 = 256 * ((pn - 13) & 3) + 32 * wc + 8 * fq;
#pragma unroll
            for (int ai = 0; ai < 2; ++ai)
#pragma unroll
                for (int m = 0; m < 4; ++m) { GAS f16* rowp = O + (size_t)(row0 + ai * 128 + m * 16) * 1024 + col0;
#pragma unroll
                    for (int bj = 0; bj < 2; ++bj) *(GAS h8*)(rowp + 128 * bj) = pack8(sigm4(acc[ai][bj][m][0]), sigm4(acc[ai][bj][m][1])); }
        }
    }
};

__device__ __forceinline__ void h8_to_f(h8 v, f32x4& a, f32x4& b) {
    f32x8 f = __builtin_convertvector(v, f32x8);
    a = (f32x4){f[0], f[1], f[2], f[3]}; b = (f32x4){f[4], f[5], f[6], f[7]};
}

template <int MODE> struct EpiN {
    static constexpr bool PERM = true, AFTER_DRAIN = false;
    GAS f16* O16; const GAS f16* G16; const GAS float* RES; GAS float* OUT; GAS float* SSW; const GAS float* SSR; const GAS f16* R16;
    __device__ __forceinline__ void operator()(const f32x4 (&acc)[2][2][4][2], const pg8::Unit& u, int wr, int wc, int fr, int fq) const {
        const int row0 = u.pm * 256 + wr * 64 + fr, col0 = u.pn * 256 + 32 * wc + 8 * fq;
#pragma unroll
        for (int ai = 0; ai < 2; ++ai)
#pragma unroll
            for (int m = 0; m < 4; ++m) {
                const size_t row = (size_t)(row0 + ai * 128 + m * 16);
                float rstd = 1.f, ss = 0.f;
                if (MODE == 4) { const GAS f32x4* sp = (const GAS f32x4*)(SSR + row * 16); f32x4 s = (sp[0] + sp[1]) + (sp[2] + sp[3]);
                    rstd = __builtin_amdgcn_rsqf(((s[0] + s[1]) + (s[2] + s[3])) * (1.f / 1024.f) + EPS); }
#pragma unroll
                for (int bj = 0; bj < 2; ++bj) {
                    const size_t off = row * 1024 + col0 + 128 * bj;
                    const f32x4 a0 = acc[ai][bj][m][0], a1 = acc[ai][bj][m][1];
                    if (MODE == 0) { f32x4 g0, g1; h8_to_f(*(const GAS h8*)(G16 + off), g0, g1); *(GAS h8*)(O16 + off) = pack8(g0 * a0, g1 * a1); }
                    if (MODE == 1) { f32x4 g0, g1, p0, p1; h8_to_f(*(const GAS h8*)(G16 + off), g0, g1); h8_to_f(*(const GAS h8*)(O16 + off), p0, p1); *(GAS h8*)(O16 + off) = pack8(p0 + g0 * a0, p1 + g1 * a1); }
                    if (MODE == 2) { const f32x4 x0 = *(const GAS f32x4*)(RES + off) + a0, x1 = *(const GAS f32x4*)(RES + off + 4) + a1;
                        *(GAS h8*)(O16 + off) = pack8(x0, x1); ss += sq4(x0) + sq4(x1); }
                    if (MODE == 5) { f32x4 r0, r1; h8_to_f(*(const GAS h8*)(R16 + off), r0, r1); const f32x4 x0 = r0 + a0, x1 = r1 + a1;
                        *(GAS h8*)(O16 + off) = pack8(x0, x1); ss += sq4(x0) + sq4(x1); }
                    if (MODE == 3) { *(GAS h8*)(O16 + off) = pack8(a0, a1); }
                    if (MODE == 4) { f32x4 g0, g1; h8_to_f(*(const GAS h8*)(G16 + off), g0, g1);
                        f32x4 r0, r1; h8_to_f(*(const GAS h8*)(R16 + off), r0, r1);
                        const f32x4 x0 = r0 + sigm4(a0 * rstd) * g0, x1 = r1 + sigm4(a1 * rstd) * g1;
                        *(GAS f32x4*)(OUT + off) = x0; *(GAS f32x4*)(OUT + off + 4) = x1; }
                }
                if (MODE == 2 || MODE == 5) { ss += __shfl_xor(ss, 16); ss += __shfl_xor(ss, 32); if (fq == 0) SSW[row * 16 + u.pn * 4 + wc] = ss; }
                asm volatile("" ::: "memory");
            }
    }
};

struct EpiGU {
    static constexpr bool PERM = true, AFTER_DRAIN = false;
    GAS f16* ACT; const LAS float* tab; const LAS int* pml;
    __device__ __forceinline__ void operator()(const f32x4 (&acc)[2][2][4][2], const pg8::Unit& u, int wr, int wc, int fr, int fq) const {
        const int row0 = u.pm * 256 + wr * 64 + fr, col0 = u.pn * 128 + 32 * wc + 8 * fq;
        int slot = 0;
#pragma unroll
        for (int j = 1; j < 16; ++j) slot = (pml[j] == u.pm) ? j : slot;
        slot = (pml[0] == u.pm) ? 0 : slot;
        const LAS float* tb = tab + slot * 256 + wr * 64 + fr;
#pragma unroll
        for (int ai = 0; ai < 2; ++ai)
#pragma unroll
            for (int m = 0; m < 4; ++m) {
                const size_t row = (size_t)(row0 + ai * 128 + m * 16);
                const float rstd = tb[ai * 128 + m * 16];
                const f32x4 g0 = acc[ai][0][m][0] * rstd, g1 = acc[ai][0][m][1] * rstd, u0 = acc[ai][1][m][0] * rstd, u1 = acc[ai][1][m][1] * rstd;
                *(GAS h8*)(ACT + row * DFF + col0) = pack8(g0 * sigm4(g0) * u0, g1 * sigm4(g1) * u1);
                asm volatile("" ::: "memory");
            }
    }
};

__device__ __forceinline__ void tr_item(const GAS float* W, int ldn, int k0, int src0, GAS f16* WT, int K, int dst0, const GAS float* gk, LAS float* scr, int lane) {
    const GAS float* wp = W + (size_t)(k0 + (lane >> 5)) * ldn + src0 + (lane & 31);
    float v[32];
#pragma unroll
    for (int i = 0; i < 32; ++i) v[i] = wp[(size_t)(2 * i) * ldn];
    const int c = lane & 7;
    f32x4 g0 = {1.f, 1.f, 1.f, 1.f}, g1 = {1.f, 1.f, 1.f, 1.f};
    if (gk) { g0 = *(const GAS f32x4*)(gk + k0 + 8 * c); g1 = *(const GAS f32x4*)(gk + k0 + 8 * c + 4); }
    __builtin_amdgcn_sched_barrier(0);
#pragma unroll
    for (int i = 0; i < 32; ++i) scr[(2 * i + (lane >> 5)) * 33 + (lane & 31)] = v[i];
    asm volatile("s_waitcnt lgkmcnt(0)" ::: "memory");
#pragma unroll
    for (int j = 0; j < 4; ++j) { const int n = (lane >> 3) + 8 * j; const LAS float* s = scr + (8 * c) * 33 + n;
        f32x8 o = {s[0] * g0[0], s[33] * g0[1], s[66] * g0[2], s[99] * g0[3], s[132] * g1[0], s[165] * g1[1], s[198] * g1[2], s[231] * g1[3]};
        *(GAS h8*)(WT + (size_t)(dst0 + n) * K + k0 + 8 * c) = __builtin_convertvector(o, h8); }
    asm volatile("s_waitcnt lgkmcnt(0)" ::: "memory");
}

template <int MODE> __device__ __forceinline__ void phase0(KP P, LAS unsigned char* lds, int gw, int NGW, int wave, int lane) {
    GAS unsigned char* ws = ((GAS unsigned char*)P->ws);
    LAS float* scr = (LAS float*)(lds + wave * 16384);
    constexpr int I1 = 16 * 168, I2 = 8 * 32, I4 = 16 * 32, I5 = 16 * 176, I6 = 44 * 32, I7 = 16 * 32, I8 = 4 * 32;
    constexpr int NIT = I1 + 2 * I2 + I4 + I5 + I6 + I7 + I8;
    if (MODE & 5) for (int it = ((MODE & 1) ? 0 : I1) + gw; it < ((MODE & 4) ? NIT : I1); it += NGW) {
        int r = it;
        if (r < I1) { const int kb = r / 168, grp = r % 168, pn = grp >> 3, g = grp & 7; int src0;
            if (pn < 4) src0 = ((pn < 2) ? 0 : 512) + 64 * (4 * (pn & 1) + (g & 3)) + 32 * (g >> 2);
            else if (pn < 8) src0 = 1024 + 256 * (pn - 4) + 32 * g;
            else if (pn == 8) src0 = (g < 2) ? 2048 + 32 * g : 2112;
            else if (pn < 13) src0 = (g < 4) ? 2120 + 128 * (pn - 9) + 32 * g : 2632 + 128 * (pn - 9) + 32 * (g - 4);
            else src0 = 3144 + 256 * (pn - 13) + 32 * g;
            tr_item(((const GAS float*)P->in[3]), INW, 64 * kb, src0, (GAS f16*)(ws + WS_W1T), 1024, 32 * grp, nullptr, scr, lane); continue; } r -= I1;
        if (r < I2) { tr_item(((const GAS float*)P->in[10]), 1024, 64 * (r / 32), 32 * (r % 32), (GAS f16*)(ws + WS_WAOT), 512, 32 * (r % 32), nullptr, scr, lane); continue; } r -= I2;
        if (r < I2) { tr_item(((const GAS float*)P->in[11]), 1024, 64 * (r / 32), 32 * (r % 32), (GAS f16*)(ws + WS_WCOT), 512, 32 * (r % 32), nullptr, scr, lane); continue; } r -= I2;
        if (r < I4) { tr_item(((const GAS float*)P->in[12]), 1024, 64 * (r / 32), 32 * (r % 32), (GAS f16*)(ws + WS_WOUTT), 1024, 32 * (r % 32), nullptr, scr, lane); continue; } r -= I4;
        if (r < I5) { const int kb = r / 176, grp = r % 176, j = grp >> 3, g = grp & 7;
            tr_item((g < 4) ? ((const GAS float*)P->in[14]) : ((const GAS float*)P->in[15]), DFF, 64 * kb, 128 * j + 32 * (g & 3), (GAS f16*)(ws + WS_WGUT), 1024, 32 * grp, ((const GAS float*)P->in[13]), scr, lane); continue; } r -= I5;
        if (r < I6) { tr_item(((const GAS float*)P->in[16]), 1024, 64 * (r / 32), 32 * (r % 32), (GAS f16*)(ws + WS_WDT), DFF, 32 * (r % 32), nullptr, scr, lane); continue; } r -= I6;
        if (r < I7) { tr_item(((const GAS float*)P->in[18]), 1024, 64 * (r / 32), 32 * (r % 32), (GAS f16*)(ws + WS_WPGT), 1024, 32 * (r % 32), ((const GAS float*)P->in[17]), scr, lane); continue; } r -= I7;
        tr_item(((const GAS float*)P->in[19]), 1024, 64 * (r / 32), 32 * (r % 32), (GAS f16*)(ws + WS_WPPT), 256, 32 * (r % 32), nullptr, scr, lane);
    }
    const GAS float* gm = ((const GAS float*)P->in[2]);
    f32x4 gv[4];
#pragma unroll
    for (int j = 0; j < 4; ++j) gv[j] = *((const GAS f32x4*)gm + lane + 64 * j);
    if (MODE & 2) for (int m0 = gw; m0 < TT; m0 += 2 * NGW) {
        const int m1 = (m0 + NGW < TT) ? m0 + NGW : m0;
        f32x4 v[2][4]; f32x4 pv[2]; float s[2] = {0.f, 0.f};
#pragma unroll
        for (int u = 0; u < 2; ++u) { const int m = u ? m1 : m0; const GAS f32x4* xr = (const GAS f32x4*)(((const GAS float*)P->in[0]) + (size_t)m * DM) + lane;
#pragma unroll
            for (int j = 0; j < 4; ++j) v[u][j] = __builtin_nontemporal_load(xr + 64 * j);
            pv[u] = __builtin_nontemporal_load((const GAS f32x4*)(((const GAS float*)P->in[1]) + (size_t)m * 256) + lane); }
#pragma unroll
        for (int u = 0; u < 2; ++u) {
            const int m = u ? m1 : m0;
#pragma unroll
            for (int j = 0; j < 4; ++j) s[u] += sq4(v[u][j]);
            const float rstd = __builtin_amdgcn_rsqf(wave_sum(s[u]) * (1.f / DM) + EPS);
            GAS f16* orow = (GAS f16*)(ws + WS_H) + (size_t)m * DM;
            typedef _Float16 h4 __attribute__((ext_vector_type(4)));
#pragma unroll
            for (int j = 0; j < 4; ++j) { f32x4 o = v[u][j] * rstd * gv[j]; *(GAS h4*)(orow + 4 * lane + 256 * j) = __builtin_convertvector(o, h4); }
            *(GAS h4*)((GAS f16*)(ws + WS_P16) + (size_t)m * 256 + 4 * lane) = __builtin_convertvector(pv[u], h4);
        }
    }
}

__device__ __forceinline__ void conv_phase(KP P, LAS unsigned char* lds, int gw, int NGW, int tid, int lane) {
    LAS float* cw = (LAS float*)lds;
    for (int i = tid; i < 31 * 512; i += 512) cw[i] = ((const GAS float*)P->in[6])[i];
    __syncthreads();
    const GAS f16* GLU = (const GAS f16*)(((GAS unsigned char*)P->ws) + WS_GLU); GAS f16* CONV = (GAS f16*)(((GAS unsigned char*)P->ws) + WS_CONV);
    const h8 zero8 = {0, 0, 0, 0, 0, 0, 0, 0};
    for (int ch = gw; ch < TT / 8; ch += NGW) {
        const int tok0 = 8 * ch, tl = tok0 & (SEQ - 1);
        float acc[8][8];
#pragma unroll
        for (int i = 0; i < 8; ++i)
#pragma unroll
            for (int c = 0; c < 8; ++c) acc[i][c] = 0.f;
        h8 buf[2][8];
#define CONV_LOAD(cc) do { _Pragma("unroll") for (int r = 0; r < 8; ++r) { const int rr = 8 * (cc) + r; if (rr < 38) { const int d = rr - 30; const bool ok = (tl + d >= 0); \
            const h8 x = *(const GAS h8*)(GLU + (size_t)(tok0 + (ok ? d : -tl)) * 512 + 8 * lane); buf[(cc) & 1][r] = ok ? x : zero8; } } } while (0)
        CONV_LOAD(0);
#pragma unroll
        for (int c = 0; c < 5; ++c) {
            __builtin_amdgcn_sched_barrier(0);
            if (c + 1 < 5) CONV_LOAD(c + 1);
            __builtin_amdgcn_sched_barrier(0);
#pragma unroll
            for (int r = 0; r < 8; ++r) {
                const int rr = 8 * c + r;
                if (rr < 38) {
                    const u32x4 xw = __builtin_bit_cast(u32x4, buf[c & 1][r]);
#pragma unroll
                    for (int i = 0; i < 8; ++i) {
                        const int j = rr - i;
                        if (j >= 0 && j <= 30) {
                            const f32x4 w0 = *(const LAS f32x4*)(cw + j * 512 + 8 * lane), w1 = *(const LAS f32x4*)(cw + j * 512 + 8 * lane + 4);
#pragma unroll
                            for (int e = 0; e < 4; ++e) { const float wl = (e < 2) ? w0[2 * e] : w1[2 * e - 4], wh = (e < 2) ? w0[2 * e + 1] : w1[2 * e - 3];
                                asm("v_fma_mix_f32 %0, %1, %2, %0 op_sel_hi:[0,1,0]" : "+v"(acc[i][2 * e]) : "v"(wl), "v"(xw[e]));
                                asm("v_fma_mix_f32 %0, %1, %2, %0 op_sel:[0,1,0] op_sel_hi:[0,1,0]" : "+v"(acc[i][2 * e + 1]) : "v"(wh), "v"(xw[e])); }
                        }
                    }
                }
            }
        }
#undef CONV_LOAD
        const f32x4 b0 = *(const GAS f32x4*)(((const GAS float*)P->in[7]) + 8 * lane), b1 = *(const GAS f32x4*)(((const GAS float*)P->in[7]) + 8 * lane + 4);
        const f32x4 g0 = *(const GAS f32x4*)(((const GAS float*)P->in[8]) + 8 * lane), g1 = *(const GAS f32x4*)(((const GAS float*)P->in[8]) + 8 * lane + 4);
        const f32x4 l0 = *(const GAS f32x4*)(((const GAS float*)P->in[9]) + 8 * lane), l1 = *(const GAS f32x4*)(((const GAS float*)P->in[9]) + 8 * lane + 4);
#pragma unroll
        for (int i = 0; i < 8; ++i) {
            f32x4 y0 = {acc[i][0], acc[i][1], acc[i][2], acc[i][3]}, y1 = {acc[i][4], acc[i][5], acc[i][6], acc[i][7]};
            y0 += b0; y1 += b1;
            const float mu = wave_sum((y0[0] + y0[1]) + (y0[2] + y0[3]) + (y1[0] + y1[1]) + (y1[2] + y1[3])) * (1.f / 512.f);
            y0 -= mu; y1 -= mu;
            const float rstd = __builtin_amdgcn_rsqf(wave_sum(sq4(y0) + sq4(y1)) * (1.f / 512.f) + EPS);
            y0 = y0 * rstd * g0 + l0; y1 = y1 * rstd * g1 + l1;
            *(GAS h8*)(CONV + (size_t)(tok0 + i) * 512 + 8 * lane) = pack8(y0 * sigm4(y0), y1 * sigm4(y1));
        }
    }
    __syncthreads();
}

__device__ __forceinline__ void find_bin(LAS unsigned* H, int lane, unsigned need, unsigned& bin, unsigned& rem) {
    const u32x4 h = *(const LAS u32x4*)(H + 4 * lane);
    const unsigned c4 = (h[0] + h[1]) + (h[2] + h[3]);
    unsigned S = c4;
#pragma unroll
    for (int o = 1; o < 64; o <<= 1) { const unsigned t = __shfl_down(S, o); if (lane + o < 64) S += t; }
    unsigned a = S - c4, fb = 0, fr = 0; bool found = false;
#pragma unroll
    for (int b = 3; b >= 0; --b) { const unsigned hb = h[b]; if (!found && a < need && a + hb >= need) { found = true; fb = 4 * lane + b; fr = need - a; } a += hb; }
    const unsigned long long mk = __ballot(found);
    const int src = mk ? (__ffsll((long long)mk) - 1) : 0;
    bin = __shfl(fb, src); rem = __shfl(fr, src);
}

template <int MODE> __device__ __forceinline__ void indexer_pair(LAS unsigned char* lds, const GAS f16* KI, int b, int t0, int ntiles, int tile, int n, int g,
        const h8 (&A)[2][4], const float (&w)[2][2][8], const h8 (&BA)[4], const h8 (&BB)[4], h8 (&NA)[4], h8 (&NB)[4]) {
    LAS unsigned short* KS = (LAS unsigned short*)lds;
        const bool hasB = tile + NW < ntiles;
        const int tna = (tile + 2 * NW < ntiles) ? tile + 2 * NW : tile, tnb = (tile + 3 * NW < ntiles) ? tile + 3 * NW : tna;
        const GAS h8* pa = (const GAS h8*)(KI + (size_t)(b * SEQ + tna * 32 + n) * 64 + 32 * g);
        const GAS h8* pb = (const GAS h8*)(KI + (size_t)(b * SEQ + tnb * 32 + n) * 64 + 32 * g);
        #pragma unroll
        for (int kk = 0; kk < 4; ++kk) { NA[kk] = pa[kk]; NB[kk] = pb[kk]; }
        f32x16 cA[2], cB[2];
#pragma unroll
        for (int mt = 0; mt < 2; ++mt) { cA[mt] = __builtin_amdgcn_mfma_f32_32x32x16_f16(A[mt][0], BA[0], f32x16{}, 0, 0, 0); cB[mt] = __builtin_amdgcn_mfma_f32_32x32x16_f16(A[mt][0], BB[0], f32x16{}, 0, 0, 0); }
#pragma unroll
        for (int kk = 1; kk < 4; ++kk)
#pragma unroll
            for (int mt = 0; mt < 2; ++mt) { cA[mt] = __builtin_amdgcn_mfma_f32_32x32x16_f16(A[mt][kk], BA[kk], cA[mt], 0, 0, 0); cB[mt] = __builtin_amdgcn_mfma_f32_32x32x16_f16(A[mt][kk], BB[kk], cB[mt], 0, 0, 0); }
#pragma unroll
        for (int u = 0; u < 2; ++u) {
            const int s = (tile + u * NW) * 32 + n;
            if (u == 0 || hasB) {
#pragma unroll
                for (int mt = 0; mt < 2; ++mt)
#pragma unroll
                    for (int qq = 0; qq < 2; ++qq) {
                        float sc = 0.f;
#pragma unroll
                        for (int h = 0; h < 8; ++h) sc += w[mt][qq][h] * fmaxf(u ? cB[mt][8 * qq + h] : cA[mt][8 * qq + h], 0.f);
                        const int ql = 4 * mt + 2 * g + qq;
                        int key = (int)(sc * 4096.f + 32768.5f);
                        key = key < 1 ? 1 : (key > 65535 ? 65535 : key);
                        if (s > t0 + ql) key = 0;
                        KS[ql * SEQ + s] = (unsigned short)key;
                        __hip_atomic_fetch_add((LAS unsigned*)(lds + 131072) + ql * 256 + (key >> 8), 1u, __ATOMIC_RELAXED, __HIP_MEMORY_SCOPE_WORKGROUP);
                    }
            }
        }
}

template <int MODE> __device__ __forceinline__ void indexer_item(KP P, LAS unsigned char* lds, int b, int t0, int wave, int lane) {
    LAS unsigned short* KS = (LAS unsigned short*)lds;
    const GAS f16* QI = (const GAS f16*)(((GAS unsigned char*)P->ws) + WS_QI); const GAS f16* KI = (const GAS f16*)(((GAS unsigned char*)P->ws) + WS_KI); const GAS float* WI = (const GAS float*)(((GAS unsigned char*)P->ws) + WS_WI);
    const int ntiles = (t0 + 8 + 31) >> 5, nkp = ntiles * 32;
    const int n = lane & 31, g = lane >> 5;
    h8 A[2][4]; float w[2][2][8];
#pragma unroll
    for (int mt = 0; mt < 2; ++mt) {
        const int ql = 2 * ((n >> 2) & 1) + (n >> 4), head = 4 * ((n >> 3) & 1) + (n & 3);
        const GAS h8* src = (const GAS h8*)(QI + (size_t)(b * SEQ + t0 + 4 * mt + ql) * 512 + head * 64 + 32 * g);
#pragma unroll
        for (int kk = 0; kk < 4; ++kk) A[mt][kk] = src[kk];
#pragma unroll
        for (int qq = 0; qq < 2; ++qq) { const GAS float* wp = WI + (size_t)(b * SEQ + t0 + 4 * mt + 2 * g + qq) * 8;
            const f32x4 wa = *(const GAS f32x4*)wp, wb = *(const GAS f32x4*)(wp + 4);
#pragma unroll
            for (int h = 0; h < 4; ++h) { w[mt][qq][h] = wa[h]; w[mt][qq][4 + h] = wb[h]; } }
    }
    h8 B0a[4], B0b[4], B1a[4], B1b[4];
    {   const int ta = (wave < ntiles) ? wave : 0, tb = (wave + NW < ntiles) ? wave + NW : ta;
        const GAS h8* pa = (const GAS h8*)(KI + (size_t)(b * SEQ + ta * 32 + n) * 64 + 32 * g);
        const GAS h8* pb = (const GAS h8*)(KI + (size_t)(b * SEQ + tb * 32 + n) * 64 + 32 * g);
#pragma unroll
        for (int kk = 0; kk < 4; ++kk) { B0a[kk] = pa[kk]; B0b[kk] = pb[kk]; } }
    for (int tile = wave; tile < ntiles; tile += 4 * NW) {
        indexer_pair<MODE>(lds, KI, b, t0, ntiles, tile, n, g, A, w, B0a, B0b, B1a, B1b);
        if (tile + 2 * NW < ntiles) indexer_pair<MODE>(lds, KI, b, t0, ntiles, tile + 2 * NW, n, g, A, w, B1a, B1b, B0a, B0b);
    }
    __syncthreads();
    if (MODE & 1) {
        const int t = t0 + wave;
        LAS unsigned short* row = KS + wave * SEQ;
        LAS unsigned* H = (LAS unsigned*)(lds + 131072 + wave * 1024);
        unsigned B1, r1; find_bin(H, lane, 256u, B1, r1);
        *(LAS u32x4*)(H + 4 * lane) = (u32x4){0u, 0u, 0u, 0u};
        for (int s8 = 8 * lane; s8 < nkp; s8 += 512) {
            const u32x4 v = *(const LAS u32x4*)(row + s8);
#pragma unroll
            for (int e = 0; e < 4; ++e) { const unsigned lo = v[e] & 0xffffu, hi = v[e] >> 16;
                if ((lo >> 8) == B1) __hip_atomic_fetch_add(H + (lo & 255u), 1u, __ATOMIC_RELAXED, __HIP_MEMORY_SCOPE_WORKGROUP);
                if ((hi >> 8) == B1) __hip_atomic_fetch_add(H + (hi & 255u), 1u, __ATOMIC_RELAXED, __HIP_MEMORY_SCOPE_WORKGROUP); }
        }
        asm volatile("s_waitcnt lgkmcnt(0)" ::: "memory");
        unsigned B2, r2; find_bin(H, lane, r1, B2, r2);
        *(LAS u32x4*)(H + 4 * lane) = (u32x4){0u, 0u, 0u, 0u};
        const unsigned T = (B1 << 8) | B2;
        LAS unsigned char* mimg = (LAS unsigned char*)(lds + 139264 + wave * 1024);
        *(LAS u32x4*)(mimg + 16 * lane) = (u32x4){0u, 0u, 0u, 0u};
        unsigned eqseen = 0;
        const unsigned long long ltmask = (1ull << lane) - 1ull;
        for (int sb = 0; sb < nkp; sb += 512) {
            const int s8 = sb + 8 * lane;
            u32x4 v = {0u, 0u, 0u, 0u};
            if (s8 < nkp) v = *(const LAS u32x4*)(row + s8);
            unsigned kk[8];
#pragma unroll
            for (int e = 0; e < 4; ++e) { kk[2 * e] = v[e] & 0xffffu; kk[2 * e + 1] = v[e] >> 16; }
            unsigned eqb = 0, gtb = 0;
#pragma unroll
            for (int e = 0; e < 8; ++e) { eqb |= (kk[e] == T) ? (1u << e) : 0u; gtb |= (kk[e] > T) ? (1u << e) : 0u; }
            unsigned takeeq = 0;
            if (__ballot(eqb != 0u)) {
                unsigned lower = 0, tot = 0;
#pragma unroll
                for (int e = 0; e < 8; ++e) { const unsigned long long m = __ballot((eqb >> e) & 1u); lower += (unsigned)__popcll(m & ltmask); tot += (unsigned)__popcll(m); }
#pragma unroll
                for (int e = 0; e < 8; ++e) { const unsigned rk = eqseen + lower + (unsigned)__builtin_popcount(eqb & ((1u << e) - 1u)); if (((eqb >> e) & 1u) && rk < r2) takeeq |= 1u << e; }
                eqseen += tot;
            }
            if (s8 < nkp) mimg[s8 >> 3] = (unsigned char)(gtb | takeeq);
        }
        asm volatile("s_waitcnt lgkmcnt(0)" ::: "memory");
        {   GAS unsigned long long* mo = (GAS unsigned long long*)(((GAS unsigned char*)P->ws) + WS_MASK) + (size_t)b * 128 * SEQ + t;
            const int ntq = 4 * ((t >> 8) + 1);
#pragma unroll
            for (int h2 = 0; h2 < 2; ++h2) { const int tile = lane + 64 * h2;
                if (tile < ntq) { const u32x4 dummy = {0u, 0u, 0u, 0u}; (void)dummy;
                    const unsigned lo = *(const LAS unsigned*)(mimg + 8 * tile), hi = *(const LAS unsigned*)(mimg + 8 * tile + 4);
                    mo[(size_t)tile * SEQ] = (unsigned long long)lo | ((unsigned long long)hi << 32); } }
        }
        asm volatile("s_waitcnt lgkmcnt(0)" ::: "memory");
    }
    __syncthreads();
}

__device__ __forceinline__ void causal_masks(KP P, int b, int t, int lane) {
    if (lane < 4) { const int rel = t - 64 * lane;
        const unsigned long long m = (rel >= 63) ? ~0ull : (rel < 0 ? 0ull : ((1ull << (rel + 1)) - 1ull));
        ((GAS unsigned long long*)(((GAS unsigned char*)P->ws) + WS_MASK))[((size_t)b * 128 + lane) * SEQ + t] = m; }
}
template <int MODE> __device__ __forceinline__ void indexer_phase(KP P, LAS unsigned char* lds, int G, int c, int wave, int lane) {
    *(LAS u32x4*)(lds + 131072 + (wave * 64 + lane) * 16) = (u32x4){0u, 0u, 0u, 0u};
    __syncthreads();
    if (G == 256) {
        for (int rr = 0; rr < 8; ++rr) { const int b = rr >> 2, q = rr & 3;
            const int blk = (q == 0) ? c : (q == 1) ? 511 - c : (q == 2) ? 512 + c : 1023 - c;
            if (8 * blk + 7 >= 256) indexer_item<MODE>(P, lds, b, 8 * blk, wave, lane); else causal_masks(P, b, 8 * blk + wave, lane); }
    } else {
        for (int it = c; it < 2048; it += G) { const int b = it >> 10, blk = it & 1023; if (8 * blk + 7 >= 256) indexer_item<MODE>(P, lds, b, 8 * blk, wave, lane); else causal_masks(P, b, 8 * blk + wave, lane); }
    }
}

__device__ __forceinline__ float dot8(h8 a, h8 b) {
    float r = __builtin_amdgcn_fdot2(__builtin_shufflevector(a, a, 0, 1), __builtin_shufflevector(b, b, 0, 1), 0.f, false);
    r = __builtin_amdgcn_fdot2(__builtin_shufflevector(a, a, 2, 3), __builtin_shufflevector(b, b, 2, 3), r, false);
    r = __builtin_amdgcn_fdot2(__builtin_shufflevector(a, a, 4, 5), __builtin_shufflevector(b, b, 4, 5), r, false);
    r = __builtin_amdgcn_fdot2(__builtin_shufflevector(a, a, 6, 7), __builtin_shufflevector(b, b, 6, 7), r, false);
    return r;
}
__device__ __forceinline__ void attn_phase(KP P, int gw, int NGW, int lane) {
    const GAS f16* Q = (const GAS f16*)(((GAS unsigned char*)P->ws) + WS_Q); const GAS f16* K = (const GAS f16*)(((GAS unsigned char*)P->ws) + WS_K); const GAS f16* V = (const GAS f16*)(((GAS unsigned char*)P->ws) + WS_V);
    GAS f16* ATT = (GAS f16*)(((GAS unsigned char*)P->ws) + WS_ATT); const GAS unsigned short* SEL = (const GAS unsigned short*)(((GAS unsigned char*)P->ws) + WS_SEL);
    const int kslot = lane >> 3, sub = lane & 7;
    for (int tok = gw; tok < TT; tok += NGW) {
        const int t = tok & (SEQ - 1), b = tok >> 13;
        const int nsel = (t + 1 < 256) ? t + 1 : 256; const bool implicit = t < 256;
        const int nit = (nsel + 7) >> 3;
        h8 q[8];
#pragma unroll
        for (int c = 0; c < 8; ++c) q[c] = *(const GAS h8*)(Q + (size_t)tok * 512 + 64 * c + 8 * sub);
        float den[8], acc[8][8];
#pragma unroll
        for (int c = 0; c < 8; ++c) { den[c] = 0.f;
#pragma unroll
            for (int d = 0; d < 8; ++d) acc[c][d] = 0.f; }
        const GAS unsigned short* selp = SEL + (size_t)tok * 256;
        for (int it = 0; it < nit; ++it) {
            const int j = 8 * it + kslot; const bool valid = j < nsel;
            int s = 0;
            if (valid) s = implicit ? j : (int)selp[j];
            const size_t ro = (size_t)(b * SEQ + s) * 512 + 8 * sub;
            h8 kv[8], vv[8];
#pragma unroll
            for (int c = 0; c < 8; ++c) kv[c] = *(const GAS h8*)(K + ro + 64 * c);
#pragma unroll
            for (int c = 0; c < 8; ++c) vv[c] = *(const GAS h8*)(V + ro + 64 * c);
#pragma unroll
            for (int c = 0; c < 8; ++c) {
                float pt = dot8(q[c], kv[c]);
                pt += __shfl_xor(pt, 1); pt += __shfl_xor(pt, 2); pt += __shfl_xor(pt, 4);
                const float p = valid ? __expf(pt) : 0.f;
                den[c] += p;
                const f32x8 vf = __builtin_convertvector(vv[c], f32x8);
#pragma unroll
                for (int d = 0; d < 8; ++d) acc[c][d] += p * vf[d];
            }
        }
#pragma unroll
        for (int c = 0; c < 8; ++c) {
            den[c] += __shfl_xor(den[c], 8); den[c] += __shfl_xor(den[c], 16); den[c] += __shfl_xor(den[c], 32);
#pragma unroll
            for (int d = 0; d < 8; ++d) { float a = acc[c][d]; a += __shfl_xor(a, 8); a += __shfl_xor(a, 16); a += __shfl_xor(a, 32); acc[c][d] = a; }
        }
#pragma unroll
        for (int c = 0; c < 8; ++c) if (kslot == c) {
            const float inv = 1.f / den[c];
            f32x8 o;
#pragma unroll
            for (int d = 0; d < 8; ++d) o[d] = acc[c][d] * inv;
            *(GAS h8*)(ATT + (size_t)tok * 512 + 64 * c + 8 * sub) = __builtin_convertvector(o, h8);
        }
    }
}


__device__ __forceinline__ float dpp_ror8(float x) { return __builtin_bit_cast(float, __builtin_amdgcn_update_dpp(0, __builtin_bit_cast(int, x), 0x128, 0xf, 0xf, false)); }
__device__ __forceinline__ void attn_phase2(KP P, int gw, int NGW, int lane) {
    const GAS f16* Q = (const GAS f16*)(((GAS unsigned char*)P->ws) + WS_Q); const GAS f16* K = (const GAS f16*)(((GAS unsigned char*)P->ws) + WS_K); const GAS f16* V = (const GAS f16*)(((GAS unsigned char*)P->ws) + WS_V);
    GAS f16* ATT = (GAS f16*)(((GAS unsigned char*)P->ws) + WS_ATT); const GAS unsigned short* SEL = (const GAS unsigned short*)(((GAS unsigned char*)P->ws) + WS_SEL);
    const int r = lane & 15, g = lane >> 4, hh = r & 7, half = r >> 3;
    const h8 zero8 = {0, 0, 0, 0, 0, 0, 0, 0};
    for (int tok = gw; tok < TT; tok += NGW) {
        const int t = tok & (SEQ - 1), b = tok >> 13;
        const int nsel = (t + 1 < 256) ? t + 1 : 256; const bool implicit = t < 256;
        const int nit = (nsel + 15) >> 4;
        h8 qf[2];
#pragma unroll
        for (int e = 0; e < 2; ++e) qf[e] = (r < 8) ? *(const GAS h8*)(Q + (size_t)tok * 512 + 64 * r + 32 * e + 8 * g) : zero8;
        const GAS unsigned short* selp = SEL + (size_t)tok * 256;
        const GAS f16* Kb = K + (size_t)b * SEQ * 512 + 8 * g; const GAS f16* Vb = V + (size_t)b * SEQ * 512 + 64 * hh + 32 * half;
        int sr, sv[4];
        if (implicit) { sr = (r < nsel) ? r : 0;
#pragma unroll
            for (int i = 0; i < 4; ++i) sv[i] = (4 * g + i < nsel) ? 4 * g + i : 0; }
        else { sr = selp[r]; const unsigned long long w = *(const GAS unsigned long long*)(selp + 4 * g);
#pragma unroll
            for (int i = 0; i < 4; ++i) sv[i] = (int)((w >> (16 * i)) & 0xffffu); }
        h8 kf[16], vf[4][4];
#pragma unroll
        for (int s = 0; s < 16; ++s) kf[s] = *(const GAS h8*)(Kb + (size_t)sr * 512 + 32 * s);
#pragma unroll
        for (int i = 0; i < 4; ++i)
#pragma unroll
            for (int c = 0; c < 4; ++c) vf[i][c] = *(const GAS h8*)(Vb + (size_t)sv[i] * 512 + 8 * c);
        float acc[32], den = 0.f;
#pragma unroll
        for (int d = 0; d < 32; ++d) acc[d] = 0.f;
        for (int it = 0; it < nit; ++it) {
            const bool more = it + 1 < nit;
            int srn = 0, svn[4] = {0, 0, 0, 0};
            if (more) {
                const int j0 = 16 * (it + 1);
                if (implicit) { srn = (j0 + r < nsel) ? j0 + r : 0;
#pragma unroll
                    for (int i = 0; i < 4; ++i) svn[i] = (j0 + 4 * g + i < nsel) ? j0 + 4 * g + i : 0; }
                else { srn = selp[j0 + r]; const unsigned long long w = *(const GAS unsigned long long*)(selp + j0 + 4 * g);
#pragma unroll
                    for (int i = 0; i < 4; ++i) svn[i] = (int)((w >> (16 * i)) & 0xffffu); }
            }
            f32x4 c = {0.f, 0.f, 0.f, 0.f};
            int rr = r; asm volatile("" : "+v"(rr));
#pragma unroll
            for (int s = 0; s < 16; ++s) { const h8 bq = (rr == (s >> 1)) ? qf[s & 1] : zero8; c = __builtin_amdgcn_mfma_f32_16x16x32_f16(kf[s], bq, c, 0, 0, 0); }
            if (more) {
#pragma unroll
                for (int s = 0; s < 16; ++s) kf[s] = *(const GAS h8*)(Kb + (size_t)srn * 512 + 32 * s);
            }
            float p[4];
#pragma unroll
            for (int i = 0; i < 4; ++i) { const int j = 16 * it + 4 * g + i; float pi = (j < nsel && r < 8) ? __expf(c[i]) : 0.f; den += pi; p[i] = pi + dpp_ror8(pi); }
#pragma unroll
            for (int i = 0; i < 4; ++i)
#pragma unroll
                for (int cc = 0; cc < 4; ++cc)
#pragma unroll
                    for (int e = 0; e < 4; ++e) { const unsigned vw = __builtin_bit_cast(u32x4, vf[i][cc])[e];
                        asm("v_fma_mix_f32 %0, %1, %2, %0 op_sel_hi:[0,1,0]" : "+v"(acc[8 * cc + 2 * e]) : "v"(p[i]), "v"(vw));
                        asm("v_fma_mix_f32 %0, %1, %2, %0 op_sel:[0,1,0] op_sel_hi:[0,1,0]" : "+v"(acc[8 * cc + 2 * e + 1]) : "v"(p[i]), "v"(vw)); }
            if (more) {
#pragma unroll
                for (int i = 0; i < 4; ++i)
#pragma unroll
                    for (int cc = 0; cc < 4; ++cc) vf[i][cc] = *(const GAS h8*)(Vb + (size_t)svn[i] * 512 + 8 * cc);
            }
        }
        den += dpp_ror8(den);
        den += __shfl_xor(den, 16); den += __shfl_xor(den, 32);
        const float inv = 1.f / den;
#pragma unroll
        for (int d = 0; d < 32; ++d) { float a = acc[d]; a += __shfl_xor(a, 16); a += __shfl_xor(a, 32); acc[d] = a * inv; }
#pragma unroll
        for (int cc = 0; cc < 4; ++cc) if (g == cc) {
            f32x8 o;
#pragma unroll
            for (int e = 0; e < 8; ++e) o[e] = acc[8 * cc + e];
            *(GAS h8*)(ATT + (size_t)tok * 512 + 64 * hh + 32 * half + 8 * cc) = __builtin_convertvector(o, h8);
        }
    }
}


template <int L> __device__ __forceinline__ float bcast_row(float x) { return __builtin_bit_cast(float, __builtin_amdgcn_update_dpp(0, __builtin_bit_cast(int, x), 0x150 + L, 0xf, 0xf, false)); }
#define PV_STEP(i, cc) do { const float pa = bcast_row<2 * (cc)>(p[i]), pb = bcast_row<2 * (cc) + 1>(p[i]); const float pp = hi ? pb : pa; \
    _Pragma("unroll") for (int e = 0; e < 4; ++e) { const unsigned vw = __builtin_bit_cast(u32x4, vf[i][cc])[e]; \
        asm("v_fma_mix_f32 %0, %1, %2, %0 op_sel_hi:[0,1,0]" : "+v"(acc[8 * (cc) + 2 * e]) : "v"(pp), "v"(vw)); \
        asm("v_fma_mix_f32 %0, %1, %2, %0 op_sel:[0,1,0] op_sel_hi:[0,1,0]" : "+v"(acc[8 * (cc) + 2 * e + 1]) : "v"(pp), "v"(vw)); } } while (0)
__device__ __forceinline__ void attn_phase3(KP P, LAS unsigned char* lds, int gw, int NGW, int wave, int lane) {
    const GAS f16* Q = (const GAS f16*)(((GAS unsigned char*)P->ws) + WS_Q); const GAS f16* K = (const GAS f16*)(((GAS unsigned char*)P->ws) + WS_K); const GAS f16* V = (const GAS f16*)(((GAS unsigned char*)P->ws) + WS_V);
    GAS f16* ATT = (GAS f16*)(((GAS unsigned char*)P->ws) + WS_ATT); const GAS unsigned short* SEL = (const GAS unsigned short*)(((GAS unsigned char*)P->ws) + WS_SEL);
    const int r = lane & 15, g = lane >> 4; const bool hi = (r >> 3) != 0;
    const h8 zero8 = {0, 0, 0, 0, 0, 0, 0, 0};
    LAS unsigned short* sidx = (LAS unsigned short*)(lds + wave * 512);
    for (int tok = gw; tok < TT; tok += NGW) {
        const int t = tok & (SEQ - 1), b = tok >> 13;
        const int nsel = (t + 1 < 256) ? t + 1 : 256; const bool implicit = t < 256;
        const int nit = (nsel + 15) >> 4;
        const GAS unsigned short* selp = SEL + (size_t)tok * 256;
        {   unsigned long long w;
            if (implicit) { w = 0ull;
#pragma unroll
                for (int k = 0; k < 4; ++k) { const int j = 4 * lane + k; w |= (unsigned long long)((j < nsel) ? j : 0) << (16 * k); } }
            else w = *(const GAS unsigned long long*)(selp + 4 * lane);
            *(LAS unsigned long long*)(sidx + 4 * lane) = w; }
        h8 qf[2];
#pragma unroll
        for (int e = 0; e < 2; ++e) qf[e] = (r < 8) ? *(const GAS h8*)(Q + (size_t)tok * 512 + 64 * r + 32 * e + 8 * g) : zero8;
        const GAS f16* Kb = K + (size_t)b * SEQ * 512 + 8 * g; const GAS f16* Vb = V + (size_t)b * SEQ * 512 + 8 * r;
        int sr = sidx[r]; unsigned long long sw = *(const LAS unsigned long long*)(sidx + 4 * g);
        h8 kf[16], vf[4][4];
#pragma unroll
        for (int s = 0; s < 16; ++s) kf[s] = *(const GAS h8*)(Kb + (size_t)sr * 512 + 32 * s);
#pragma unroll
        for (int i = 0; i < 4; ++i) { const int sv = (int)((sw >> (16 * i)) & 0xffffu);
#pragma unroll
            for (int c = 0; c < 4; ++c) vf[i][c] = *(const GAS h8*)(Vb + (size_t)sv * 512 + 128 * c); }
        float acc[32], den = 0.f;
#pragma unroll
        for (int d = 0; d < 32; ++d) acc[d] = 0.f;
        for (int it = 0; it < nit; ++it) {
            const int itn = (it + 1 < nit) ? it + 1 : 0;
            sr = sidx[16 * itn + r]; sw = *(const LAS unsigned long long*)(sidx + 16 * itn + 4 * g);
            f32x4 c = {0.f, 0.f, 0.f, 0.f};
            int rr = r; asm volatile("" : "+v"(rr));
#pragma unroll
            for (int s = 0; s < 16; ++s) { const h8 bq = (rr == (s >> 1)) ? qf[s & 1] : zero8; c = __builtin_amdgcn_mfma_f32_16x16x32_f16(kf[s], bq, c, 0, 0, 0); }
            __builtin_amdgcn_sched_barrier(0);
#pragma unroll
            for (int s = 0; s < 16; ++s) kf[s] = *(const GAS h8*)(Kb + (size_t)sr * 512 + 32 * s);
            __builtin_amdgcn_sched_barrier(0);
            float p[4];
#pragma unroll
            for (int i = 0; i < 4; ++i) { const int j = 16 * it + 4 * g + i; p[i] = (j < nsel && r < 8) ? __expf(c[i]) : 0.f; den += p[i]; }
#pragma unroll
            for (int i = 0; i < 4; ++i) { PV_STEP(i, 0); PV_STEP(i, 1); PV_STEP(i, 2); PV_STEP(i, 3); }
            __builtin_amdgcn_sched_barrier(0);
#pragma unroll
            for (int i = 0; i < 4; ++i) { const int sv = (int)((sw >> (16 * i)) & 0xffffu);
#pragma unroll
                for (int cc = 0; cc < 4; ++cc) vf[i][cc] = *(const GAS h8*)(Vb + (size_t)sv * 512 + 128 * cc); }
        }
        den += __shfl_xor(den, 16); den += __shfl_xor(den, 32);
        float dinv[4];
        { const float d0 = bcast_row<0>(den), d1 = bcast_row<1>(den), d2 = bcast_row<2>(den), d3 = bcast_row<3>(den), d4 = bcast_row<4>(den), d5 = bcast_row<5>(den), d6 = bcast_row<6>(den), d7 = bcast_row<7>(den);
          dinv[0] = 1.f / (hi ? d1 : d0); dinv[1] = 1.f / (hi ? d3 : d2); dinv[2] = 1.f / (hi ? d5 : d4); dinv[3] = 1.f / (hi ? d7 : d6); }
#pragma unroll
        for (int d = 0; d < 32; ++d) { float a = acc[d]; a += __shfl_xor(a, 16); a += __shfl_xor(a, 32); acc[d] = a * dinv[d >> 3]; }
#pragma unroll
        for (int cc = 0; cc < 4; ++cc) if (g == cc) {
            f32x8 o;
#pragma unroll
            for (int e = 0; e < 8; ++e) o[e] = acc[8 * cc + e];
            *(GAS h8*)(ATT + (size_t)tok * 512 + 128 * cc + 8 * r) = __builtin_convertvector(o, h8);
        }
    }
}


template <int CTRL> __device__ __forceinline__ float dpp_add(float x) { return x + __builtin_bit_cast(float, __builtin_amdgcn_update_dpp(0, __builtin_bit_cast(int, x), CTRL, 0xf, 0xf, false)); }
__device__ __forceinline__ void attn_phase4(KP P, LAS unsigned char* lds, int gw, int NGW, int wave, int lane) {
    const GAS f16* Q = (const GAS f16*)(((GAS unsigned char*)P->ws) + WS_Q); const GAS f16* K = (const GAS f16*)(((GAS unsigned char*)P->ws) + WS_K); const GAS f16* V = (const GAS f16*)(((GAS unsigned char*)P->ws) + WS_V);
    GAS f16* ATT = (GAS f16*)(((GAS unsigned char*)P->ws) + WS_ATT); const GAS unsigned short* SEL = (const GAS unsigned short*)(((GAS unsigned char*)P->ws) + WS_SEL);
    const int kslot = lane >> 3, sub = lane & 7;
    LAS unsigned short* sidx = (LAS unsigned short*)(lds + wave * 512);
    for (int tok = gw; tok < TT; tok += NGW) {
        const int t = tok & (SEQ - 1), b = tok >> 13;
        const int nsel = (t + 1 < 256) ? t + 1 : 256; const bool implicit = t < 256;
        const int nit = (nsel + 7) >> 3;
        const GAS unsigned short* selp = SEL + (size_t)tok * 256;
        {   unsigned long long w;
            if (implicit) { w = 0ull;
#pragma unroll
                for (int k = 0; k < 4; ++k) { const int j = 4 * lane + k; w |= (unsigned long long)((j < nsel) ? j : 0) << (16 * k); } }
            else w = *(const GAS unsigned long long*)(selp + 4 * lane);
            asm volatile("" ::: "memory");
#pragma unroll
            for (int k = 0; k < 4; ++k) sidx[4 * lane + k] = (unsigned short)((w >> (16 * k)) & 0xffffull);
            asm volatile("s_waitcnt lgkmcnt(0)" ::: "memory"); }
        h8 q[8];
#pragma unroll
        for (int c = 0; c < 8; ++c) q[c] = *(const GAS h8*)(Q + (size_t)tok * 512 + 64 * c + 8 * sub);
        float den[8], acc[8][8];
#pragma unroll
        for (int c = 0; c < 8; ++c) { den[c] = 0.f;
#pragma unroll
            for (int d = 0; d < 8; ++d) acc[c][d] = 0.f; }
        const GAS f16* Kb = K + (size_t)b * SEQ * 512 + 8 * sub; const GAS f16* Vb = V + (size_t)b * SEQ * 512 + 8 * sub;
        int s = sidx[kslot];
        h8 kv[8], vv[8];
#pragma unroll
        for (int c = 0; c < 8; ++c) kv[c] = *(const GAS h8*)(Kb + (size_t)s * 512 + 64 * c);
#pragma unroll
        for (int c = 0; c < 8; ++c) vv[c] = *(const GAS h8*)(Vb + (size_t)s * 512 + 64 * c);
        for (int it = 0; it < nit; ++it) {
            const int itn = (it + 1 < nit) ? it + 1 : 0;
            s = sidx[8 * itn + kslot];
            const bool valid = (8 * it + kslot) < nsel;
            float p[8];
#pragma unroll
            for (int c = 0; c < 8; ++c) { float pt = dot8(q[c], kv[c]); pt = dpp_add<0xB1>(pt); pt = dpp_add<0x4E>(pt); pt = dpp_add<0x141>(pt); p[c] = pt; }
            __builtin_amdgcn_sched_barrier(0);
#pragma unroll
            for (int c = 0; c < 8; ++c) kv[c] = *(const GAS h8*)(Kb + (size_t)s * 512 + 64 * c);
            __builtin_amdgcn_sched_barrier(0);
#pragma unroll
            for (int c = 0; c < 8; ++c) {
                const float pe = valid ? __expf(p[c]) : 0.f;
                den[c] += pe;
#pragma unroll
                for (int e = 0; e < 4; ++e) { const unsigned vw = __builtin_bit_cast(u32x4, vv[c])[e];
                    asm("v_fma_mix_f32 %0, %1, %2, %0 op_sel_hi:[0,1,0]" : "+v"(acc[c][2 * e]) : "v"(pe), "v"(vw));
                    asm("v_fma_mix_f32 %0, %1, %2, %0 op_sel:[0,1,0] op_sel_hi:[0,1,0]" : "+v"(acc[c][2 * e + 1]) : "v"(pe), "v"(vw)); }
            }
            __builtin_amdgcn_sched_barrier(0);
#pragma unroll
            for (int c = 0; c < 8; ++c) vv[c] = *(const GAS h8*)(Vb + (size_t)s * 512 + 64 * c);
        }
#pragma unroll
        for (int c = 0; c < 8; ++c) {
            den[c] += __shfl_xor(den[c], 8); den[c] += __shfl_xor(den[c], 16); den[c] += __shfl_xor(den[c], 32);
#pragma unroll
            for (int d = 0; d < 8; ++d) { float a = acc[c][d]; a += __shfl_xor(a, 8); a += __shfl_xor(a, 16); a += __shfl_xor(a, 32); acc[c][d] = a; }
        }
#pragma unroll
        for (int c = 0; c < 8; ++c) if (kslot == c) {
            const float inv = 1.f / den[c];
            f32x8 o;
#pragma unroll
            for (int d = 0; d < 8; ++d) o[d] = acc[c][d] * inv;
            *(GAS h8*)(ATT + (size_t)tok * 512 + 64 * c + 8 * sub) = __builtin_convertvector(o, h8);
        }
    }
}

#define XB_TMO      128
#define XB_XCNT(j)  (256  + 64 * (j))
#define XB_XSUB(j)  (1280 + 64 * (j))
#define XB_XGEN(j)  (2304 + 64 * (j))
#define XB_TOP      3328
#define XB_TOPGEN   3392
#define XCD_BAR_WORDS 3456
#define XB_SPIN_CAP (1u << 18)

__device__ __forceinline__ unsigned xb_ld(unsigned* p)              { return __hip_atomic_load(p, __ATOMIC_RELAXED, __HIP_MEMORY_SCOPE_AGENT); }
__device__ __forceinline__ unsigned xb_add(unsigned* p, unsigned v) { return __hip_atomic_fetch_add(p, v, __ATOMIC_RELAXED, __HIP_MEMORY_SCOPE_AGENT); }
__device__ __forceinline__ unsigned xb_xcc_id() { return (unsigned)__builtin_amdgcn_s_getreg((3 << 11) | 20) & 0xFu; }
#define XB_SPIN(cond, bar) do { unsigned _sp = 0; while (cond) { __builtin_amdgcn_s_sleep(1); \
    if ((++_sp & 255u) == 0u) { if (xb_ld(&(bar)[XB_TMO])) break; if (_sp > XB_SPIN_CAP) { atomicAdd(&(bar)[XB_TMO], 1u); break; } } } } while (0)

struct XcdBarrier {
    unsigned* bar; unsigned x;
    volatile LAS unsigned* st;
};

__device__ __forceinline__ XcdBarrier xcd_barrier_post(unsigned* bar, volatile LAS unsigned* st) {
    XcdBarrier b; b.bar = bar; b.x = xb_xcc_id(); b.st = st;
    if (threadIdx.x == 0) (void)xb_add(&bar[XB_XCNT(b.x)], 1u);
    return b;
}
__device__ __forceinline__ void xcd_barrier_complete(unsigned* bar, unsigned x, unsigned& nloc, unsigned& nx) {
    const unsigned G = gridDim.x * gridDim.y * gridDim.z;
    unsigned sum, cnt, mine, sp = 0u;
    for (;;) {
        sum = 0u; cnt = 0u; mine = 0u;
#pragma unroll
        for (unsigned j = 0; j < 16; ++j) { const unsigned c = xb_ld(&bar[XB_XCNT(j)]); sum += c; cnt += (c > 0u) ? 1u : 0u; mine = (j == x) ? c : mine; }
        if (sum == G) break;
        __builtin_amdgcn_s_sleep(1);
        if ((++sp & 255u) == 0u) { if (xb_ld(&bar[XB_TMO])) break; if (sp > XB_SPIN_CAP) { atomicAdd(&bar[XB_TMO], 1u); break; } }
    }
    nloc = mine > 0u ? mine : 1u; nx = cnt > 0u ? cnt : 1u;
}

__device__ __forceinline__ void xcd_barrier(const XcdBarrier& b) {
    asm volatile("s_waitcnt vmcnt(0)" ::: "memory");
    __syncthreads();
    if (threadIdx.x == 0) {
        unsigned* bar = b.bar;
        __builtin_amdgcn_s_waitcnt(0);
        unsigned nloc = b.st[0], nx = b.st[1];
        if (nloc == 0u) { xcd_barrier_complete(bar, b.x, nloc, nx); b.st[0] = nloc; b.st[1] = nx; }
        const unsigned old = xb_add(&bar[XB_XSUB(b.x)], 1u);
        const unsigned gen = old / nloc;
        if (old + 1u == (gen + 1u) * nloc) {
            __builtin_amdgcn_fence(__ATOMIC_RELEASE, "agent");
            asm volatile("s_waitcnt vmcnt(0)" ::: "memory");
            const unsigned og = xb_add(&bar[XB_TOP], 1u);
            const unsigned tg = og / nx;
            if (og + 1u == (tg + 1u) * nx) xb_add(&bar[XB_TOPGEN], 1u);
            else XB_SPIN(xb_ld(&bar[XB_TOPGEN]) == tg, bar);
            __builtin_amdgcn_fence(__ATOMIC_ACQUIRE, "agent");
            xb_add(&bar[XB_XGEN(b.x)], 1u);
            asm volatile("s_waitcnt vmcnt(0)" ::: "memory");
        } else {
            XB_SPIN(xb_ld(&bar[XB_XGEN(b.x)]) == gen, bar);
            __builtin_amdgcn_fence(__ATOMIC_ACQUIRE, "agent");
            asm volatile("s_waitcnt vmcnt(0)" ::: "memory");
        }
    }
    __syncthreads();
}


#define GEMM_PHASE(EPI, epi, Aoff, Boff, NN, KK) do { int kk_ = (KK); asm volatile("" : "+s"(kk_)); pg8::Gemm g{(const pg8::bf16_t*)(ws + (Aoff)), (const pg8::bf16_t*)(ws + (Boff)), TT, (NN), kk_}; \
    pg8::StaticOrder S; S.init(TT, (NN), G, (int)blockIdx.x); pg8::gemm_phase<EPI, pg8::StaticOrder, true, true>(lds, g, S, epi, wave); } while (0)

__device__ __forceinline__ KP opaque_params() { KP p = (KP)__builtin_amdgcn_kernarg_segment_ptr(); asm volatile("" : "+s"(p)); return p; }
__global__ void __launch_bounds__(512) mega_fwd(Params P_) {
    extern __shared__ __attribute__((aligned(16))) unsigned char lds_raw[];
    LAS unsigned char* lds = (LAS unsigned char*)lds_raw;
    cg::grid_group grid = cg::this_grid();
    if (threadIdx.x < 16) ((LAS unsigned*)(lds + LDS_BYTES - 64))[threadIdx.x] = 0u;
    __syncthreads();
    const XcdBarrier xbar = xcd_barrier_post((unsigned*)(P_.ws + 65536), (volatile LAS unsigned*)(lds + LDS_BYTES - 64));
    const int wave = __builtin_amdgcn_readfirstlane(threadIdx.x >> 6);
    const int G = gridDim.x, bx = blockIdx.x;
    const int gw = bx * NW + wave, NGW = G * NW;
    GAS unsigned char* ws = (GAS unsigned char*)P_.ws;
#define LANEID(l) int l; asm volatile("v_mbcnt_lo_u32_b32 %0, -1, 0\n\tv_mbcnt_hi_u32_b32 %0, -1, %0" : "=v"(l))
#define PP (opaque_params())
    GAS f16* const GAp = (GAS f16*)(ws + WS_GA); GAS f16* const GCp = (GAS f16*)(ws + WS_GC);
    GAS float* const SS1 = (GAS float*)(ws + WS_SS1); GAS float* const SS2 = (GAS float*)(ws + WS_SS2);

    { LANEID(lane); phase0<7>(PP, lds, gw, NGW, wave, lane); }
    if (gridDim.x == 0x7fffffffu) grid.sync();
    xcd_barrier(xbar);
    {   LAS float* gtab = (LAS float*)(lds + 131072);
        if (threadIdx.x < 128) gtab[threadIdx.x] = (threadIdx.x < 64) ? ((const GAS float*)PP->in[4])[threadIdx.x] : ((const GAS float*)PP->in[5])[threadIdx.x - 64];
        __syncthreads();
        EpiG1 E{ws, gtab}; GEMM_PHASE(EpiG1, E, WS_H, WS_W1T, N1, 1024); }
    xcd_barrier(xbar);
    { LANEID(lane); conv_phase(PP, lds, gw, NGW, wave * 64 + lane, lane); }
    { LANEID(lane); indexer_phase<1>(PP, lds, G, bx, wave, lane); }
    xcd_barrier(xbar);
    { const attn_body::AttnTensors AT{(const attn_body::bf16*)(P_.ws + WS_Q), (const attn_body::bf16*)(P_.ws + WS_K), (const attn_body::bf16*)(P_.ws + WS_V), (attn_body::bf16*)(P_.ws + WS_ATT), (const unsigned long long*)(P_.ws + WS_MASK)};
      const attn_body::StaticOrder S(G, bx);
      bool safe;
      {   LANEID(lane); float gq = __builtin_fabsf(((const GAS float*)PP->in[4])[lane]), gk = __builtin_fabsf(((const GAS float*)PP->in[5])[lane]);
#pragma unroll
          for (int o = 1; o < 64; o <<= 1) { gq = fmaxf(gq, __shfl_xor(gq, o)); gk = fmaxf(gk, __shfl_xor(gk, o)); }
          safe = __builtin_amdgcn_readfirstlane((11.6f * gq * gk < 60.f) ? 1 : 0) != 0; }
      attn_body::attn_phase<attn_body::StaticOrder>((char*)lds_raw, AT, S, safe); }
    xcd_barrier(xbar);
    { EpiN<0> E{(GAS f16*)(ws + WS_MERGED), GAp, nullptr, nullptr, nullptr, nullptr, nullptr}; GEMM_PHASE(EpiN<0>, E, WS_ATT, WS_WAOT, 1024, 512); }
    { EpiN<1> E{(GAS f16*)(ws + WS_MERGED), GCp, nullptr, nullptr, nullptr, nullptr, nullptr}; GEMM_PHASE(EpiN<1>, E, WS_CONV, WS_WCOT, 1024, 512); }
    xcd_barrier(xbar);
    { EpiN<2> E{(GAS f16*)(ws + WS_X1H), nullptr, ((const GAS float*)PP->in[0]), nullptr, SS1, nullptr, nullptr}; GEMM_PHASE(EpiN<2>, E, WS_MERGED, WS_WOUTT, 1024, 1024); }
    xcd_barrier(xbar);
    {   LAS float* tab = (LAS float*)(lds + 131072); LAS int* pml = (LAS int*)(lds + 131072 + 16384);
        {   pg8::StaticOrder S0; S0.init(TT, NGU, G, (int)blockIdx.x); pg8::Unit u0; LANEID(lane);
            const int t = wave * 64 + lane;
            for (int i = 0; i < 16; ++i) {
                const bool ok = S0.next(i, u0);
                if (t == 0) pml[i] = ok ? u0.pm : -1;
                if (ok && t < 256) { const GAS f32x4* sp = (const GAS f32x4*)(SS1 + (size_t)(u0.pm * 256 + t) * 16); const f32x4 s = (sp[0] + sp[1]) + (sp[2] + sp[3]);
                    tab[i * 256 + t] = __builtin_amdgcn_rsqf(((s[0] + s[1]) + (s[2] + s[3])) * (1.f / 1024.f) + EPS); }
            }
            __syncthreads(); }
        EpiGU E{(GAS f16*)(ws + WS_ACT), tab, pml}; GEMM_PHASE(EpiGU, E, WS_X1H, WS_WGUT, NGU, 1024); }
    if (G == 256 && bx >= 128) {
        EpiN<3> E{(GAS f16*)(ws + WS_TMP), nullptr, nullptr, nullptr, nullptr, nullptr, nullptr};
        int kk_ = 256; asm volatile("" : "+s"(kk_));
        pg8::Gemm g{(const pg8::bf16_t*)(ws + WS_P16), (const pg8::bf16_t*)(ws + WS_WPPT), TT, 1024, kk_};
        pg8::StaticOrder S; S.init(TT, 1024, 128, (int)blockIdx.x - 128);
        pg8::gemm_phase<EpiN<3>, pg8::StaticOrder, true, true>(lds, g, S, E, wave);
    }
    xcd_barrier(xbar);
    { EpiN<5> E{(GAS f16*)(ws + WS_X2H), nullptr, nullptr, nullptr, SS2, nullptr, (const GAS f16*)(ws + WS_X1H)}; GEMM_PHASE(EpiN<5>, E, WS_ACT, WS_WDT, 1024, DFF); }
    xcd_barrier(xbar);
    if (G != 256) { EpiN<3> E{(GAS f16*)(ws + WS_TMP), nullptr, nullptr, nullptr, nullptr, nullptr, nullptr}; GEMM_PHASE(EpiN<3>, E, WS_P16, WS_WPPT, 1024, 256); }
    { EpiN<4> E{nullptr, (const GAS f16*)(ws + WS_TMP), nullptr, ((GAS float*)PP->out), nullptr, SS2, (const GAS f16*)(ws + WS_X2H)}; GEMM_PHASE(EpiN<4>, E, WS_X2H, WS_WPGT, 1024, 1024); }
}

extern "C" void kernel_launch(void* const* d_in, const int* in_sizes, int n_in, void* d_out, int out_size, void* d_ws, size_t ws_size, hipStream_t stream) {
    static int grid = 0;
    if (grid == 0) {
        if (n_in != 20 || out_size != TT * DM || ws_size < WS_END) { fprintf(stderr, "kernel_launch: unexpected problem shape (n_in %d out %d ws %zu)\n", n_in, out_size, ws_size); grid = -1; return; }
        int dev = 0, cus = 0, per_cu = 0;
        hipGetDevice(&dev); hipDeviceGetAttribute(&cus, hipDeviceAttributeMultiprocessorCount, dev);
        if (hipFuncSetAttribute((const void*)mega_fwd, hipFuncAttributeMaxDynamicSharedMemorySize, LDS_BYTES) != hipSuccess) { fprintf(stderr, "kernel_launch: hipFuncSetAttribute failed\n"); grid = -1; return; }
        if (hipOccupancyMaxActiveBlocksPerMultiprocessor(&per_cu, (const void*)mega_fwd, 512, LDS_BYTES) != hipSuccess || per_cu < 1) { fprintf(stderr, "kernel_launch: occupancy query says %d\n", per_cu); per_cu = 1; }
        (void)hipGetLastError();
        grid = cus;
    }
    if (grid < 0) return;
    if (hipMemsetAsync(d_ws, 0, 1u << 20, stream) != hipSuccess) { fprintf(stderr, "kernel_launch: memset failed\n"); return; }
    Params p{};
    for (int i = 0; i < 20; ++i) p.in[i] = (const float*)d_in[i];
    p.out = (float*)d_out; p.ws = (unsigned char*)d_ws;
    void* args[] = {&p};
    hipError_t e = hipLaunchCooperativeKernel((const void*)mega_fwd, dim3(grid), dim3(512), args, LDS_BYTES, stream);
    if (e != hipSuccess) fprintf(stderr, "cooperative launch failed: %s (grid %d)\n", hipGetErrorString(e), grid);
}
```

```cpp
#include <hip/hip_runtime.h>
#include <hip/hip_cooperative_groups.h>
#include <hip/hip_bf16.h>
#include <cmath>
#include <cstdio>
#include <cstdint>
namespace cg = cooperative_groups;
namespace pg8 {
#define PG8_LAS __attribute__((address_space(3)))
typedef unsigned short bf16_t;
typedef _Float16 bf16x8 __attribute__((ext_vector_type(8)));
typedef float f32x4 __attribute__((ext_vector_type(4)));
typedef unsigned u32x4 __attribute__((ext_vector_type(4)));
constexpr int BM = 256, BK = 64, HALF = 128, HTB = HALF * BK * 2  , STAGE_BYTES = 8 * HTB, NXCD = 8, WGM = 8;

__host__ __device__ __forceinline__ int lds_byte(int r, int c) { const int st = (r >> 4) * 2 + (c >> 5), rr = r & 15, cc = c & 31, ob = rr * 64 + cc * 2; return st * 1024 + (ob ^ (((ob >> 9) & 1) << 5)); }
__host__ __device__ __forceinline__ void stage_rc(int b, int& R, int& C) { const int st = b / 1024, sb = b % 1024, swz = sb ^ (((sb >> 9) & 1) << 5); R = (st >> 1) * 16 + swz / 64; C = (st & 1) * 32 + (swz % 64) / 2; }
__host__ __device__ __forceinline__ int perm32(int rho) { const int n = rho >> 4, i = rho & 15; return 8 * (i >> 2) + 4 * n + (i & 3); }

struct Unit { int pm, pn; };
struct Gemm { const bf16_t* A; const bf16_t* Bt; int M, N, K; };

struct StaticOrder {
    int nM, nN, nwg, G, c;
    __host__ __device__ void init(int M, int N, int G_, int c_) { nM = M / BM; nN = N / BM; nwg = nM * nN; G = G_; c = c_; }
    __host__ __device__ bool next(int i, Unit& u) const {
        const long L = (long)i * G + c; if (L >= nwg) return false;
        int wgid = (int)L; { const int q = nwg / NXCD, r = nwg % NXCD, xcd = wgid % NXCD, off = wgid / NXCD; wgid = (xcd < r ? xcd * (q + 1) : r * (q + 1) + (xcd - r) * q) + off; }
        const int nig = WGM * nN, gid = wgid / nig, fm = gid * WGM, gsz = (nM - fm) < WGM ? (nM - fm) : WGM;
        u.pm = fm + ((wgid % nig) % gsz); u.pn = (wgid % nig) / gsz; return true;
    }
    __device__ __forceinline__ void a_ready(const Unit&) const {}
    __device__ __forceinline__ void done(const Unit&) const {}
};

template <class Epi, class Sched, bool ALIGN_EPI = false, bool SP2 = false>
__device__ __forceinline__ void gemm_phase(PG8_LAS unsigned char* lds, const Gemm g, const Sched& S, const Epi& E, const int wid_in) {
    int lane; asm volatile("v_mbcnt_lo_u32_b32 %0, -1, 0\n\tv_mbcnt_hi_u32_b32 %0, -1, %0" : "=v"(lane)); const int wid = wid_in, tid = wid * 64 + lane, wr = wid >> 2, wc = wid & 3, fr = lane & 15, fq = lane >> 4;
    const int K = g.K, nt = K / BK;
    unsigned voffA[2], voffB[2];
#pragma unroll
    for (int i = 0; i < 2; ++i) { int R, C; stage_rc(tid * 16 + i * 8192, R, C); const int Rb = Epi::PERM ? ((R & ~31) + perm32(R & 31)) : R;
        voffA[i] = (unsigned)(R * K + C) * 2u; voffB[i] = (unsigned)(Rb * K + C) * 2u; }
    const size_t kstep = (size_t)(BK * 2);
    const size_t hstep = (size_t)HALF * K * 2;
    const size_t tstep = 2 * hstep;
    const unsigned ldsw = (unsigned)wid * 1024u;
    const int aoff = lds_byte(wr * 64 + fr, fq * 8), boff = lds_byte(wc * 32 + fr, fq * 8);
#define PG8_SA(b, h) (((b) * 2 + (h)) * HTB)
#define PG8_SB(b, h) ((4 + (b) * 2 + (h)) * HTB)
#define PG8_STAGE(bufoff, gbase, voff) do { _Pragma("unroll") for (int _i = 0; _i < 2; ++_i) \
        __builtin_amdgcn_global_load_lds((const unsigned*)((const char*)(gbase) + (voff)[_i]), (PG8_LAS unsigned*)(lds + (bufoff) + ldsw + _i * 8192), 16, 0, 0); } while (0)
#define PG8_LDA(dst, b, h) do { _Pragma("unroll") for (int m = 0; m < 4; ++m) _Pragma("unroll") for (int k = 0; k < 2; ++k) dst[m][k] = *(const PG8_LAS bf16x8*)(lds + PG8_SA(b, h) + aoff + m * 2048 + k * 1024); } while (0)
#define PG8_LDB(dst, b, h) do { _Pragma("unroll") for (int n = 0; n < 2; ++n) _Pragma("unroll") for (int k = 0; k < 2; ++k) dst[n][k] = *(const PG8_LAS bf16x8*)(lds + PG8_SB(b, h) + boff + n * 2048 + k * 1024); } while (0)
#define PG8_MMA(ai, bj, At, Bt) do { __builtin_amdgcn_s_setprio(1); _Pragma("unroll") for (int m = 0; m < 4; ++m) _Pragma("unroll") for (int n = 0; n < 2; ++n) _Pragma("unroll") for (int k = 0; k < 2; ++k) \
        acc[ai][bj][m][n] = __builtin_amdgcn_mfma_f32_16x16x32_f16(Bt[n][k], At[m][k], acc[ai][bj][m][n], 0, 0, 0); __builtin_amdgcn_s_setprio(0); } while (0)
#define PG8_WAIT_V(n) asm volatile("s_waitcnt vmcnt(" #n ")" ::: "memory")
#define PG8_WAIT_L(n) asm volatile("s_waitcnt lgkmcnt(" #n ")" ::: "memory")
#define PG8_BAR __builtin_amdgcn_s_barrier()
#define PG8_SCHED __builtin_amdgcn_sched_barrier(0)
    Unit cur, nxt; int ui = 0;
    if (!S.next(0, cur)) return;
    f32x4 acc[2][2][4][2];
#pragma unroll
    for (int a = 0; a < 2; ++a)
#pragma unroll
        for (int b = 0; b < 2; ++b)
#pragma unroll
            for (int m = 0; m < 4; ++m)
#pragma unroll
                for (int n = 0; n < 2; ++n) acc[a][b][m][n] = (f32x4){0.f, 0.f, 0.f, 0.f};
    bf16x8 At[4][2], B0[2][2], B1[2][2];
    const char* cA = (const char*)g.A + (size_t)cur.pm * tstep; const char* cB = (const char*)g.Bt + (size_t)cur.pn * tstep;
    S.a_ready(cur);
    if constexpr (SP2) {
        PG8_STAGE(PG8_SB(0, 0), cB, voffB); PG8_STAGE(PG8_SB(0, 1), cB + hstep, voffB); PG8_STAGE(PG8_SA(0, 0), cA, voffA); PG8_STAGE(PG8_SA(0, 1), cA + hstep, voffA);
        if (wr == 1) PG8_BAR;
        PG8_WAIT_V(2); PG8_BAR;
        PG8_STAGE(PG8_SB(1, 0), cB + kstep, voffB); PG8_STAGE(PG8_SA(1, 0), cA + kstep, voffA); PG8_STAGE(PG8_SB(1, 1), cB + hstep + kstep, voffB);
        PG8_WAIT_V(6); PG8_BAR;
    } else {
        PG8_STAGE(PG8_SB(0, 0), cB, voffB); PG8_STAGE(PG8_SA(0, 0), cA, voffA); PG8_STAGE(PG8_SB(0, 1), cB + hstep, voffB); PG8_STAGE(PG8_SA(0, 1), cA + hstep, voffA);
        if (wr == 1) PG8_BAR;
        PG8_WAIT_V(4); PG8_BAR;
        PG8_STAGE(PG8_SB(1, 0), cB + kstep, voffB); PG8_STAGE(PG8_SA(1, 0), cA + kstep, voffA); PG8_STAGE(PG8_SB(1, 1), cB + hstep + kstep, voffB);
        PG8_WAIT_V(6); PG8_BAR;
    }
    for (;;) {
        const bool has_next = S.next(ui + 1, nxt);
        const char* nA = has_next ? (const char*)g.A + (size_t)nxt.pm * tstep : cA; const char* nB = has_next ? (const char*)g.Bt + (size_t)nxt.pn * tstep : cB;
        for (int t = 0; t < nt; t += 2) {
            const bool last = (t == nt - 2);
            const char* a1 = cA + (size_t)(t + 1) * kstep;
            const char* a2 = last ? nA : cA + (size_t)(t + 2) * kstep; const char* b2 = last ? nB : cB + (size_t)(t + 2) * kstep;
            const char* a3 = a2 + kstep; const char* b3 = b2 + kstep;
            if (last && has_next) S.a_ready(nxt);
            if constexpr (SP2) {
            PG8_LDB(B0, 0, 0); PG8_LDB(B1, 0, 1); PG8_SCHED; PG8_LDA(At, 0, 0); PG8_STAGE(PG8_SA(1, 1), a1 + hstep, voffA);
            PG8_WAIT_V(8); PG8_WAIT_L(0); PG8_BAR; PG8_MMA(0, 0, At, B0); PG8_MMA(0, 1, At, B1); PG8_BAR; PG8_SCHED;
            PG8_LDA(At, 0, 1); PG8_STAGE(PG8_SB(0, 0), b2, voffB); PG8_STAGE(PG8_SB(0, 1), b2 + hstep, voffB); PG8_STAGE(PG8_SA(0, 0), a2, voffA);
            PG8_WAIT_V(8); PG8_WAIT_L(0); PG8_BAR; PG8_MMA(1, 0, At, B0); PG8_MMA(1, 1, At, B1); PG8_BAR; PG8_SCHED;
            PG8_LDB(B0, 1, 0); PG8_LDB(B1, 1, 1); PG8_SCHED; PG8_LDA(At, 1, 0); PG8_STAGE(PG8_SA(0, 1), a2 + hstep, voffA);
            PG8_WAIT_V(8); PG8_WAIT_L(0); PG8_BAR; PG8_MMA(0, 0, At, B0); PG8_MMA(0, 1, At, B1); PG8_BAR; PG8_SCHED;
            PG8_LDA(At, 1, 1); PG8_STAGE(PG8_SB(1, 0), b3, voffB); PG8_STAGE(PG8_SB(1, 1), b3 + hstep, voffB); PG8_STAGE(PG8_SA(1, 0), a3, voffA);
            PG8_WAIT_V(8); PG8_WAIT_L(0); PG8_BAR; PG8_MMA(1, 0, At, B0); PG8_MMA(1, 1, At, B1); PG8_BAR; PG8_SCHED;
            } else {
            PG8_LDB(B0, 0, 0); PG8_SCHED; PG8_LDA(At, 0, 0); PG8_STAGE(PG8_SA(1, 1), a1 + hstep, voffA);
            PG8_WAIT_L(8); PG8_BAR; PG8_WAIT_L(0); PG8_MMA(0, 0, At, B0); PG8_BAR; PG8_SCHED;
            PG8_LDB(B1, 0, 1); PG8_STAGE(PG8_SB(0, 0), b2, voffB);
            PG8_BAR; PG8_WAIT_L(0); PG8_MMA(0, 1, At, B1); PG8_BAR;
            PG8_LDA(At, 0, 1); PG8_STAGE(PG8_SA(0, 0), a2, voffA);
            PG8_BAR; PG8_WAIT_L(0); PG8_MMA(1, 0, At, B0); PG8_BAR; PG8_SCHED;
            PG8_STAGE(PG8_SB(0, 1), b2 + hstep, voffB);
            PG8_WAIT_V(6); PG8_BAR; PG8_MMA(1, 1, At, B1); PG8_BAR;
            PG8_LDB(B0, 1, 0); PG8_SCHED; PG8_LDA(At, 1, 0); PG8_STAGE(PG8_SA(0, 1), a2 + hstep, voffA);
            PG8_WAIT_L(8); PG8_BAR; PG8_WAIT_L(0); PG8_MMA(0, 0, At, B0); PG8_BAR; PG8_SCHED;
            PG8_LDB(B1, 1, 1); PG8_STAGE(PG8_SB(1, 0), b3, voffB);
            PG8_BAR; PG8_WAIT_L(0); PG8_MMA(0, 1, At, B1); PG8_BAR;
            PG8_LDA(At, 1, 1); PG8_STAGE(PG8_SA(1, 0), a3, voffA);
            PG8_BAR; PG8_WAIT_L(0); PG8_MMA(1, 0, At, B0); PG8_BAR; PG8_SCHED;
            PG8_STAGE(PG8_SB(1, 1), b3 + hstep, voffB);
            PG8_WAIT_V(6); PG8_BAR; PG8_MMA(1, 1, At, B1); PG8_BAR;
            }
        }
        if constexpr (ALIGN_EPI) { if (wr == 0) PG8_BAR; }
        if constexpr (!Epi::AFTER_DRAIN) { E(acc, cur, wr, wc, fr, fq); S.done(cur); }
        if (!has_next) break;
#pragma unroll
        for (int a = 0; a < 2; ++a)
#pragma unroll
            for (int b = 0; b < 2; ++b)
#pragma unroll
                for (int m = 0; m < 4; ++m)
#pragma unroll
                    for (int n = 0; n < 2; ++n) acc[a][b][m][n] = (f32x4){0.f, 0.f, 0.f, 0.f};
        cur = nxt; cA = nA; cB = nB; ++ui;
        if constexpr (ALIGN_EPI) { if (wr == 1) PG8_BAR; }
    }
    PG8_WAIT_V(0);
    if constexpr (!ALIGN_EPI) { if (wr == 0) PG8_BAR; }
    PG8_BAR;
    if constexpr (Epi::AFTER_DRAIN) { E.fused(acc, cur, wr, wc, fr, fq, lds, wid, lane); S.done(cur); }
#undef PG8_SA
#undef PG8_SB
#undef PG8_STAGE
#undef PG8_LDA
#undef PG8_LDB
#undef PG8_MMA
#undef PG8_WAIT_V
#undef PG8_WAIT_L
#undef PG8_BAR
#undef PG8_SCHED
}
}
namespace attn_body {
using bf16=__hip_bfloat16;
using bf16x8=__attribute__((ext_vector_type(8)))short;
using s16x4=__attribute__((ext_vector_type(4)))short;
using f32x16=__attribute__((ext_vector_type(16)))float;
using u32x4=__attribute__((ext_vector_type(4)))unsigned;
constexpr int BATCH=2,NHEAD=8,SEQ=8192,D=64,DM=NHEAD*D;
constexpr int NW=8,QBLK=32,QB=QBLK*NW,KVBLK=64,NQB=SEQ/QB;
constexpr int ATTN_PITCH=DM, ATTN_UNIT_ROWS=QB;
__device__ __forceinline__ int crow(int r,int hi){return (r&3)+8*(r>>2)+4*hi;}
#define SBAR() __builtin_amdgcn_sched_barrier(0)
__device__ __forceinline__ void cmask(f32x16&p0,f32x16&p1,int jb,int qrel,int hi){
  const float NEG=-INFINITY; int kb=64*jb+4*hi;
  #pragma unroll
  for(int r=0;r<16;++r){int kv=kb+(r&3)+8*(r>>2); if(kv>qrel)p0[r]=NEG; if(kv+32>qrel)p1[r]=NEG;}
}

__device__ __forceinline__ void smask(f32x16&p0,f32x16&p1,unsigned long long w,int hi,float mh){
  const unsigned lo=((unsigned)w)>>(4*hi), hh=((unsigned)(w>>32))>>(4*hi);
  if(__builtin_expect(__any(mh!=0.f),0)){
    #pragma unroll
    for(int r=0;r<16;++r){p0[r]-=mh;p1[r]-=mh;} }
  #pragma unroll
  for(int r=0;r<16;++r){ const unsigned bit=(unsigned)((r&3)+8*(r>>2));
    const unsigned t0=(unsigned)__builtin_amdgcn_sbfe((int)lo,bit,1u), t1=(unsigned)__builtin_amdgcn_sbfe((int)hh,bit,1u);
    float x0=p0[r],x1=p1[r];
    asm("v_bfi_b32 %0, %1, %0, %2":"+v"(x0):"v"(t0),"s"(0xFF800000u));
    asm("v_bfi_b32 %0, %1, %0, %2":"+v"(x1):"v"(t1),"s"(0xFF800000u));
    p0[r]=x0; p1[r]=x1; }
}
constexpr int NSLOT=3, SLOTB=8192;
constexpr int LDS_K=0, LDS_V=NSLOT*SLOTB, LDS_WS=2*NSLOT*SLOTB, LDS_OST=LDS_WS+NW*64*4, LDS_BYTES=LDS_OST+NW*4096;
constexpr float C2=0.125f*1.4426950408889634f;
__device__ __forceinline__ void glds16(const void*gsrc,unsigned lds_dst){unsigned keep;
  asm volatile("s_mov_b32 %0, m0\n\ts_mov_b32 m0, %2\n\ts_nop 0\n\tglobal_load_lds_dwordx4 %1, off\n\ts_mov_b32 m0, %0":"=&s"(keep):"v"(gsrc),"s"(lds_dst):"memory");}
__device__ __forceinline__ float max3f(float a,float b,float c){float r;asm("v_max3_f32 %0, %1, %2, %3":"=v"(r):"v"(a),"v"(b),"v"(c));return r;}
__device__ __forceinline__ float max2f(float a,float b){float r;asm("v_max_f32_e32 %0, %1, %2":"=v"(r):"v"(a),"v"(b));return r;}
__device__ __forceinline__ float fadd_s(float a,float b){float r;asm("v_add_f32_e32 %0, %1, %2":"=v"(r):"v"(a),"v"(b));return r;}
__device__ __forceinline__ float fsub_s(float a,float b){float r;asm("v_sub_f32_e32 %0, %1, %2":"=v"(r):"v"(a),"v"(b));return r;}
typedef float f32x2_t __attribute__((ext_vector_type(2))); typedef __bf16 bf16x2_t __attribute__((ext_vector_type(2)));
__device__ __forceinline__ unsigned cvtpk_s(float lo,float hi){f32x2_t v={lo,hi};bf16x2_t b=__builtin_convertvector(v,bf16x2_t);return __builtin_bit_cast(unsigned,b);}
#define WAIT_BAR(N) asm volatile("s_waitcnt vmcnt(" #N ") lgkmcnt(0)\n\ts_barrier":::"memory")

__device__ __forceinline__ void qkt(f32x16&p0,f32x16&p1,const char*Kslot,const bf16x8*qr,int r32,int hi){ const f32x16 negm=f32x16{};
  const char*kb=Kslot+hi*1024+r32*16;
  #pragma unroll
  for(int d0=0;d0<4;++d0){
    const bf16x8 b0=*reinterpret_cast<const bf16x8*>(kb+d0*2048);
    const bf16x8 b1=*reinterpret_cast<const bf16x8*>(kb+d0*2048+512);
    if(d0==0){p0=__builtin_amdgcn_mfma_f32_32x32x16_bf16(b0,qr[0],negm,0,0,0);p1=__builtin_amdgcn_mfma_f32_32x32x16_bf16(b1,qr[0],negm,0,0,0);}
    else{p0=__builtin_amdgcn_mfma_f32_32x32x16_bf16(b0,qr[d0],p0,0,0,0);p1=__builtin_amdgcn_mfma_f32_32x32x16_bf16(b1,qr[d0],p1,0,0,0);}}
}
typedef __attribute__((address_space(3))) const char* lds_cptr;
typedef short v4i16_t __attribute__((ext_vector_type(4)));
__device__ __forceinline__ void kload8(bf16x8*kf,lds_cptr kp){
  kf[0]=*(const __attribute__((address_space(3))) bf16x8*)(kp);      kf[1]=*(const __attribute__((address_space(3))) bf16x8*)(kp+512);
  kf[2]=*(const __attribute__((address_space(3))) bf16x8*)(kp+2048); kf[3]=*(const __attribute__((address_space(3))) bf16x8*)(kp+2560);
  kf[4]=*(const __attribute__((address_space(3))) bf16x8*)(kp+4096); kf[5]=*(const __attribute__((address_space(3))) bf16x8*)(kp+4608);
  kf[6]=*(const __attribute__((address_space(3))) bf16x8*)(kp+6144); kf[7]=*(const __attribute__((address_space(3))) bf16x8*)(kp+6656);
}
__device__ __forceinline__ void kload2(bf16x8*kf,lds_cptr kp,int j){ kf[2*j]=*(const __attribute__((address_space(3))) bf16x8*)(kp+j*2048); kf[2*j+1]=*(const __attribute__((address_space(3))) bf16x8*)(kp+j*2048+512); }
__device__ __forceinline__ s16x4 vtr(lds_cptr p){ return __builtin_bit_cast(s16x4,__builtin_amdgcn_ds_read_tr16_b64_v4i16((__attribute__((address_space(3))) v4i16_t*)p)); }
__device__ __forceinline__ float rowmax(const f32x16&p0,const f32x16&p1){
  float a=max3f(p0[0],p0[1],p1[0]),b=max3f(p0[2],p0[3],p1[1]);a=max3f(a,p1[2],p1[3]);
  #pragma unroll
  for(int r=4;r<16;r+=4){a=max3f(a,p0[r],p0[r+1]);b=max3f(b,p0[r+2],p0[r+3]);a=max3f(a,p1[r],p1[r+1]);b=max3f(b,p1[r+2],p1[r+3]);}
  const float m=max2f(a,b);
  auto rr=__builtin_amdgcn_permlane32_swap(__float_as_uint(m),__float_as_uint(m),false,false);
  return max2f(__uint_as_float(rr[0]),__uint_as_float(rr[1]));
}
__device__ __forceinline__ void pv(f32x16*o,int vb,bf16x8 pa0,bf16x8 pa1,bf16x8 pa2,bf16x8 pa3){
  #pragma unroll
  for(int d0=0;d0<2;++d0){s16x4 lo[4],hi[4];
    #pragma unroll
    for(int ks=0;ks<4;++ks){
      asm volatile("ds_read_b64_tr_b16 %0,%1 offset:%c2":"=&v"(lo[ks]):"v"(vb),"i"(d0*4096+ks*1024):"memory");
      asm volatile("ds_read_b64_tr_b16 %0,%1 offset:%c2":"=&v"(hi[ks]):"v"(vb),"i"(d0*4096+ks*1024+512):"memory");}
    asm volatile("s_waitcnt lgkmcnt(0)":::"memory");SBAR();
    #define PK(k) (bf16x8){lo[k][0],lo[k][1],lo[k][2],lo[k][3],hi[k][0],hi[k][1],hi[k][2],hi[k][3]}
    o[d0]=__builtin_amdgcn_mfma_f32_32x32x16_bf16(pa0,PK(0),o[d0],0,0,0);
    o[d0]=__builtin_amdgcn_mfma_f32_32x32x16_bf16(pa1,PK(1),o[d0],0,0,0);
    o[d0]=__builtin_amdgcn_mfma_f32_32x32x16_bf16(pa2,PK(2),o[d0],0,0,0);
    o[d0]=__builtin_amdgcn_mfma_f32_32x32x16_bf16(pa3,PK(3),o[d0],0,0,0);
    #undef PK
  }
}

#ifndef ATTN_STORE16
#define ATTN_STORE16(p,v) (*(u32x4*)(p)=(v))
#endif
template<int THRL> __device__ __forceinline__ void attn_unit(int b,int h,int qb,const bf16*Q,const bf16*__restrict__ K,const bf16*__restrict__ V,bf16*O,const unsigned long long*MT,char*shm){
  const int tid=threadIdx.x,lane=tid&63,r32=lane&31,hi=lane>>5; const int wid=__builtin_amdgcn_readfirstlane(tid>>6);
  const long rowbase=(long)b*SEQ; const int q0=qb*QB;
  const bf16*Qw=Q+(rowbase+q0+wid*QBLK)*DM+h*D;
  const bf16*Kh=K+rowbase*DM+h*D,*Vh=V+rowbase*DM+h*D;
  const unsigned lds0=(unsigned)(uintptr_t)shm;
  float*wsf=(float*)(shm+LDS_WS)+wid*64;
  const bf16*ksrc=Kh+(long)lane*DM+wid*8;
  const bf16*vsrc=Vh+(long)(16*(wid&3)+(lane>>2))*DM+(wid>>2)*32+(lane&3)*8;
  const unsigned kdst=lds0+LDS_K+wid*1024, vdst=lds0+LDS_V+wid*1024;
  #define DMA_K(t,slot) glds16(ksrc+(long)(t)*KVBLK*DM,(unsigned)__builtin_amdgcn_readfirstlane(kdst+(slot)))
  #define DMA_V(t,slot) glds16(vsrc+(long)(t)*KVBLK*DM,(unsigned)__builtin_amdgcn_readfirstlane(vdst+(slot)))
  const int vb0=(int)(lds0+LDS_V)+((lane>>4)&1)*32+(lane&3)*8+(4*hi+((lane&15)>>2))*64;
  const char*Kbase=shm+LDS_K; bf16x8 kf[8];
  const lds_cptr shm3=(lds_cptr)shm; const lds_cptr kp0=shm3+LDS_K+hi*1024+r32*16; const lds_cptr vp0=shm3+LDS_V+((lane>>4)&1)*32+(lane&3)*8+(4*hi+((lane&15)>>2))*64;
  const int NT=(q0+QB)/KVBLK;
  const unsigned long long*mrow=MT+((long)b*128)*SEQ+q0+wid*QBLK;
  unsigned long long mkA,mkB;
  #define MLOAD(var,t) asm volatile("global_load_dwordx2 %0, %1, %2":"=v"(var):"v"(r32*8),"s"(mrow+(long)(t)*SEQ):"memory")
  #define SMASK(P0,P1,var) do{ asm volatile("":"+v"(var)); smask(P0,P1,var,hi,mhat); }while(0)
  MLOAD(mkA,0);
  DMA_K(0,0);DMA_V(0,0);DMA_K(1,SLOTB);
  bf16x8 qr[4];
  #pragma unroll
  for(int d0=0;d0<4;++d0)qr[d0]=*reinterpret_cast<const bf16x8*>(&Qw[(long)r32*DM+d0*16+hi*8]);
  float mhat=0.f,l_reg=0.f;f32x16 o[2];o[0]=f32x16{};o[1]=f32x16{};
  const int qrel=wid*QBLK+r32;
  bool resc=false;
  #define START(P0,P1) do{ float rm=0.f; if constexpr(THRL<1000){ rm=rowmax(P0,P1); } resc=false; \
    { const float dl=(THRL<1000&&rm>(float)THRL)?rm:0.f; mhat=fadd_s(mhat,dl); \
      _Pragma("unroll") for(int r=0;r<16;++r){P0[r]=fsub_s(P0[r],dl);P1[r]=fsub_s(P1[r],dl);} } \
    _Pragma("unroll") for(int r=0;r<16;++r)P0[r]=__builtin_amdgcn_exp2f(P0[r]); }while(0)
  #define RESC() do{ if(resc){ asm volatile("s_waitcnt lgkmcnt(0)":::"memory"); \
      _Pragma("unroll") for(int d_=0;d_<2;++d_) _Pragma("unroll") for(int r=0;r<16;++r)o[d_][r]*=wsf[crow(r,hi)]; } }while(0)
  f32x16 pA0,pA1,pB0,pB1;
  int sl_prev=0,sl_cur=0,sl_next=SLOTB;
  #define ROT() do{sl_prev=sl_cur;sl_cur=sl_next;sl_next=(sl_next==(NSLOT-1)*SLOTB)?0:sl_next+SLOTB;}while(0)
  DMA_K(2,2*SLOTB);
  WAIT_BAR(3);
  qkt(pA0,pA1,Kbase,qr,r32,hi);asm volatile("s_nop 15\n\ts_nop 7":"+v"(pA0),"+v"(pA1));SMASK(pA0,pA1,mkA);
  START(pA0,pA1);
  _Pragma("unroll") for(int r=0;r<16;++r)pA1[r]=__builtin_amdgcn_exp2f(pA1[r]);
  WAIT_BAR(0);
  MLOAD(mkB,1);
  DMA_K(3,0);DMA_V(1,SLOTB);
  ROT();
  kload8(kf,kp0+sl_cur);
  WAIT_BAR(2);
  s16x4 vlo[8],vhi[8]; u32x4 pw0,pw1,pw2,pw3;
  #define PKW(P,B) cvtpk_s(P[B],P[B+1])
  #define PAF(k) __builtin_bit_cast(bf16x8,pw##k)
  #define VFR(i) (bf16x8){vlo[i][0],vlo[i][1],vlo[i][2],vlo[i][3],vhi[i][0],vhi[i][1],vhi[i][2],vhi[i][3]}
  #define PIN(x) asm volatile("":"+v"(x))
  #define MX3(a,b,c) __builtin_fmaxf(__builtin_fmaxf((a),(b)),(c))
  #define GAPA(MF,A0,A1,A2,A3,W0,W1,PW) do{ MF; sacc+=A0; sacc+=A1; sacc+=A2; sacc+=A3; PIN(sacc); W0; W1; PIN(PW); SBAR(); }while(0)
  #define EX(v) __builtin_amdgcn_exp2f(v)
  #define GAPB(MF,X,B) do{ MF; X[B]=EX(X[B]); X[B+1]=EX(X[B+1]); X[B+2]=EX(X[B+2]); X[B+3]=EX(X[B+3]); PIN(X); SBAR(); }while(0)
  #define VRD(i) do{ vlo[i]=vtr(vp_+(((i)>>2)*4096+((i)&3)*1024)); vhi[i]=vtr(vp_+(((i)>>2)*4096+((i)&3)*1024+512)); }while(0)
  #define KRD(G,j) do{ if(G){ kload2(kf,kp0+sl_next,j); SBAR(); } }while(0)
  #define STEP(C0,C1,P0,P1,t,GK,GV,GL,MKC,MKN) do{ SBAR(); \
    const lds_cptr vp_=vp0+sl_prev; \
    VRD(0); SBAR(); float sacc=(P0[0]+P0[1]); \
    GAPA(C0=__builtin_amdgcn_mfma_f32_32x32x16_bf16(kf[0],qr[0],f32x16{},0,0,0), P0[2],P0[3],P0[4],P0[5],     pw0[0]=PKW(P0,0), pw0[1]=PKW(P0,2), pw0); \
    VRD(4); SBAR(); GAPA(C1=__builtin_amdgcn_mfma_f32_32x32x16_bf16(kf[1],qr[0],f32x16{},0,0,0), P0[6],P0[7],P0[8],P0[9],     pw0[2]=PKW(P0,4), pw0[3]=PKW(P0,6), pw0); \
    VRD(1); SBAR(); GAPA(C0=__builtin_amdgcn_mfma_f32_32x32x16_bf16(kf[2],qr[1],C0,0,0,0),   P0[10],P0[11],P0[12],P0[13], pw1[0]=PKW(P0,8), pw1[1]=PKW(P0,10), pw1); \
    VRD(5); SBAR(); GAPA(C1=__builtin_amdgcn_mfma_f32_32x32x16_bf16(kf[3],qr[1],C1,0,0,0),   P0[14],P0[15],P1[0],P1[1],   pw1[2]=PKW(P0,12),pw1[3]=PKW(P0,14), pw1); \
    VRD(2); SBAR(); GAPA(C0=__builtin_amdgcn_mfma_f32_32x32x16_bf16(kf[4],qr[2],C0,0,0,0),   P1[2],P1[3],P1[4],P1[5],     pw2[0]=PKW(P1,0), pw2[1]=PKW(P1,2), pw2); \
    VRD(6); SBAR(); GAPA(C1=__builtin_amdgcn_mfma_f32_32x32x16_bf16(kf[5],qr[2],C1,0,0,0),   P1[6],P1[7],P1[8],P1[9],     pw2[2]=PKW(P1,4), pw2[3]=PKW(P1,6), pw2); \
    VRD(3); SBAR(); GAPA(C0=__builtin_amdgcn_mfma_f32_32x32x16_bf16(kf[6],qr[3],C0,0,0,0),   P1[10],P1[11],P1[12],P1[13], pw3[0]=PKW(P1,8), pw3[1]=PKW(P1,10), pw3); \
    VRD(7); SBAR(); GAPA(C1=__builtin_amdgcn_mfma_f32_32x32x16_bf16(kf[7],qr[3],C1,0,0,0),   P1[14],P1[15],0.f,0.f,       pw3[2]=PKW(P1,12),pw3[3]=PKW(P1,14), pw3); \
    l_reg+=sacc; \
    if((t)+1<NT){MLOAD(MKN,(t)+1);} if(GK){DMA_K((t)+3,sl_cur);} if(GV){DMA_V((t)+1,sl_next);} \
    SMASK(C0,C1,MKC); \
    resc=false; if constexpr(THRL<1000){ float a=MX3(C0[0],C0[1],C1[0]),b=MX3(C0[2],C0[3],C1[1]); a=MX3(a,C1[2],C1[3]); \
      _Pragma("unroll") for(int r=4;r<16;r+=4){a=MX3(a,C0[r],C0[r+1]);b=MX3(b,C0[r+2],C0[r+3]);a=MX3(a,C1[r],C1[r+1]);b=MX3(b,C1[r+2],C1[r+3]);} \
      float rm=__builtin_fmaxf(a,b); { auto rr=__builtin_amdgcn_permlane32_swap(__float_as_uint(rm),__float_as_uint(rm),false,false); rm=__builtin_fmaxf(__uint_as_float(rr[0]),__uint_as_float(rr[1])); } \
      if(__builtin_expect(__any(rm>(float)THRL),0)){ const float dl=__builtin_fmaxf(rm,0.f); mhat+=dl; \
        _Pragma("unroll") for(int r=0;r<16;++r){C0[r]-=dl;C1[r]-=dl;} \
        const float f=__builtin_amdgcn_exp2f(-dl); l_reg*=f; if(hi==0)wsf[r32]=f; resc=true; } } \
    SBAR(); \
    GAPB(o[0]=__builtin_amdgcn_mfma_f32_32x32x16_bf16(PAF(0),VFR(0),o[0],0,0,0), C0,0); \
    GAPB(o[1]=__builtin_amdgcn_mfma_f32_32x32x16_bf16(PAF(0),VFR(4),o[1],0,0,0), C0,4); \
    KRD(GL,0); GAPB(o[0]=__builtin_amdgcn_mfma_f32_32x32x16_bf16(PAF(1),VFR(1),o[0],0,0,0), C0,8); \
    KRD(GL,1); GAPB(o[1]=__builtin_amdgcn_mfma_f32_32x32x16_bf16(PAF(1),VFR(5),o[1],0,0,0), C0,12); \
    KRD(GL,2); GAPB(o[0]=__builtin_amdgcn_mfma_f32_32x32x16_bf16(PAF(2),VFR(2),o[0],0,0,0), C1,0); \
    KRD(GL,3); GAPB(o[1]=__builtin_amdgcn_mfma_f32_32x32x16_bf16(PAF(2),VFR(6),o[1],0,0,0), C1,4); \
    GAPB(o[0]=__builtin_amdgcn_mfma_f32_32x32x16_bf16(PAF(3),VFR(3),o[0],0,0,0), C1,8); \
    GAPB(o[1]=__builtin_amdgcn_mfma_f32_32x32x16_bf16(PAF(3),VFR(7),o[1],0,0,0), C1,12); \
    }while(0)
  int t=1;
  for(;t+5<NT;t+=2){
    STEP(pB0,pB1,pA0,pA1,t,true,true,true,mkB,mkA);     WAIT_BAR(2); RESC(); ROT();
    STEP(pA0,pA1,pB0,pB1,t+1,true,true,true,mkA,mkB);   WAIT_BAR(2); RESC(); ROT();
  }
  #define ENDW(tt) do{ if((tt)+3<NT){WAIT_BAR(2);} else if((tt)+2<NT){WAIT_BAR(1);} else {WAIT_BAR(0);} }while(0)
  for(;t+1<NT;t+=2){
    STEP(pB0,pB1,pA0,pA1,t,(t+3<NT),(t+1<NT),(t+1<NT),mkB,mkA);       ENDW(t);   RESC(); ROT();
    STEP(pA0,pA1,pB0,pB1,t+1,(t+4<NT),(t+2<NT),(t+2<NT),mkA,mkB);     ENDW(t+1); RESC(); ROT();
  }
  STEP(pB0,pB1,pA0,pA1,NT-1,false,false,false,mkB,mkA); RESC();
  { float sacc=pB0[0]+pB0[1]; _Pragma("unroll") for(int r=2;r<16;++r)sacc+=pB0[r]; _Pragma("unroll") for(int r=0;r<16;++r)sacc+=pB1[r]; l_reg+=sacc;
    pw0=(u32x4){PKW(pB0,0),PKW(pB0,2),PKW(pB0,4),PKW(pB0,6)};pw1=(u32x4){PKW(pB0,8),PKW(pB0,10),PKW(pB0,12),PKW(pB0,14)};pw2=(u32x4){PKW(pB1,0),PKW(pB1,2),PKW(pB1,4),PKW(pB1,6)};pw3=(u32x4){PKW(pB1,8),PKW(pB1,10),PKW(pB1,12),PKW(pB1,14)};
    SBAR(); pv(o,vb0+sl_cur,PAF(0),PAF(1),PAF(2),PAF(3)); }
  #undef PKW
  #undef PAF
  #undef VFR
  #undef PIN
  #undef MX3
  #undef GAPA
  #undef GAPB
  #undef EX
  #undef VRD
  #undef KRD
  #undef STEP
  #undef ENDW
  {auto rr=__builtin_amdgcn_permlane32_swap(__float_as_uint(l_reg),__float_as_uint(l_reg),false,false);l_reg=__uint_as_float(rr[0])+__uint_as_float(rr[1]);}
  if(hi==0)wsf[32+r32]=l_reg;asm volatile("s_waitcnt lgkmcnt(0)":::"memory");
  float rli[16];
  #pragma unroll
  for(int r=0;r<16;++r)rli[r]=__builtin_amdgcn_rcpf(wsf[32+crow(r,hi)]);
  bf16*Ow=O+(rowbase+q0+wid*QBLK)*DM+h*D;
  { bf16*stg=(bf16*)(shm+LDS_OST)+wid*2048;
    #pragma unroll
    for(int r=0;r<16;++r){const int orow=crow(r,hi);
      #pragma unroll
      for(int d0=0;d0<2;++d0)((_Float16*)stg)[orow*64+d0*32+r32]=(_Float16)(o[d0][r]*rli[r]);}
    asm volatile("s_waitcnt lgkmcnt(0)":::"memory");
    #pragma unroll
    for(int i=0;i<4;++i){const int row=i*8+(lane>>3),ch=lane&7; const u32x4 v=*(const u32x4*)(stg+row*64+ch*8); ATTN_STORE16(Ow+(long)row*DM+ch*8,v);} }
  asm volatile("s_waitcnt lgkmcnt(0)\n\ts_barrier":::"memory");
  #undef DMA_K
  #undef DMA_V
  #undef MLOAD
  #undef SMASK
  #undef START
  #undef RESC
  #undef ROT
}
constexpr int ATTN_LDS_BYTES=LDS_BYTES;
struct AttnTensors { const bf16* Q; const bf16* K; const bf16* V; bf16* O; const unsigned long long* MT; };
struct AttnUnit { int bh; int qb; };
struct StaticOrder {
  int vcu,grid,blk;
  __device__ __forceinline__ explicit StaticOrder(int grid_,int block):vcu((block%8)*(grid_/8)+block/8),grid(grid_),blk(block){}
  __device__ __forceinline__ bool next(int i,AttnUnit&u)const{
    if(grid!=256){ const int k=i*grid+blk; if(k>=16*NQB)return false; u.bh=k/NQB; u.qb=NQB-1-(k%NQB); return true; }
    if(i>=2)return false; const int s=vcu&15; u.bh=vcu>>4; u.qb=(i==0)?s:31-s; return true; }
  __device__ __forceinline__ void a_ready(const AttnUnit&)const{}
  __device__ __forceinline__ void done(const AttnUnit&)const{}
};
template<class Sched,int THRL=64> __device__ __forceinline__ void attn_phase(char*lds,const AttnTensors&T,const Sched&S,bool safe){
  AttnUnit u;
  for(int i=0;S.next(i,u);++i){ S.a_ready(u); if(safe) attn_unit<1000>(u.bh/NHEAD,u.bh%NHEAD,u.qb,T.Q,T.K,T.V,T.O,T.MT,lds); else attn_unit<THRL>(u.bh/NHEAD,u.bh%NHEAD,u.qb,T.Q,T.K,T.V,T.O,T.MT,lds); S.done(u); }
}
#undef SBAR
#undef WAIT_BAR
}


#define LAS __attribute__((address_space(3)))
#define GAS __attribute__((address_space(1)))
typedef _Float16 f16;
typedef _Float16 h2 __attribute__((ext_vector_type(2)));
typedef _Float16 h8 __attribute__((ext_vector_type(8)));
typedef float f32x4 __attribute__((ext_vector_type(4)));
typedef float f32x8 __attribute__((ext_vector_type(8)));
typedef float f32x16 __attribute__((ext_vector_type(16)));
typedef unsigned u32x4 __attribute__((ext_vector_type(4)));

constexpr int TT = 16384, SEQ = 8192, DM = 1024, INW = 5192, DFF = 2816, NW = 8;
constexpr float EPS = 1e-6f;
constexpr size_t MiB = 1u << 20;
constexpr size_t WS_W1T = 2 * MiB, WS_WAOT = 13 * MiB, WS_WCOT = 14 * MiB, WS_WOUTT = 15 * MiB, WS_WGUT = 17 * MiB, WS_WDT = 28 * MiB, WS_WPGT = 34 * MiB, WS_WPPT = 36 * MiB;
constexpr size_t WS_SS1 = 37 * MiB, WS_SS2 = 38 * MiB;
constexpr size_t WS_MASK = 56 * MiB;
constexpr size_t WS_H = 40 * MiB, WS_CONV = 40 * MiB, WS_X2H = 40 * MiB;
constexpr size_t WS_Q = 72 * MiB, WS_K = 88 * MiB, WS_MERGED = 72 * MiB, WS_TMP = 72 * MiB;
constexpr size_t WS_V = 104 * MiB, WS_QI = 120 * MiB, WS_X1H = 104 * MiB;
constexpr size_t WS_KI = 136 * MiB, WS_WI = 138 * MiB, WS_GLU = 140 * MiB, WS_GA = 156 * MiB, WS_GC = 188 * MiB, WS_SEL = 220 * MiB, WS_ACT = 136 * MiB;
constexpr size_t WS_ATT = 228 * MiB, WS_P16 = 244 * MiB, WS_END = 252 * MiB;
constexpr int N1 = 21 * 256, NGU = 22 * 256;
constexpr int LDS_BYTES = 148480;

struct Params { const float* in[20]; float* out; unsigned char* ws; };
typedef const __attribute__((address_space(4))) Params* KP;

__device__ __forceinline__ h8 pack8(f32x4 a, f32x4 b) {
    f32x8 v = {a[0], a[1], a[2], a[3], b[0], b[1], b[2], b[3]};
    return __builtin_convertvector(v, h8);
}
typedef __bf16 bf2v __attribute__((ext_vector_type(2)));
typedef float f32x2v __attribute__((ext_vector_type(2)));
__device__ __forceinline__ unsigned pkbf(float lo, float hi) { f32x2v v = {lo, hi}; return __builtin_bit_cast(unsigned, __builtin_convertvector(v, bf2v)); }
__device__ __forceinline__ u32x4 pack8_bf16(f32x4 a, f32x4 b) { return (u32x4){pkbf(a[0], a[1]), pkbf(a[2], a[3]), pkbf(b[0], b[1]), pkbf(b[2], b[3])}; }
__device__ __forceinline__ float sigm(float x) { return __builtin_amdgcn_rcpf(1.f + __expf(-x)); }
__device__ __forceinline__ f32x4 sigm4(f32x4 x) { f32x4 r; r[0] = sigm(x[0]); r[1] = sigm(x[1]); r[2] = sigm(x[2]); r[3] = sigm(x[3]); return r; }
__device__ __forceinline__ float wave_sum(float v) {
#pragma unroll
    for (int o = 1; o < 64; o <<= 1) v += __shfl_xor(v, o);
    return v;
}
__device__ __forceinline__ float sq4(f32x4 x) { return (x[0] * x[0] + x[1] * x[1]) + (x[2] * x[2] + x[3] * x[3]); }

struct EpiG1 {
    static constexpr bool PERM = true, AFTER_DRAIN = false;
    GAS unsigned char* wsb; const LAS float* gtab;
    __device__ __forceinline__ void operator()(const f32x4 (&acc)[2][2][4][2], const pg8::Unit& u, int wr, int wc, int fr, int fq) const {
        GAS f16* const Q = (GAS f16*)(wsb + WS_Q); GAS f16* const K = (GAS f16*)(wsb + WS_K); GAS f16* const V = (GAS f16*)(wsb + WS_V); GAS f16* const QI = (GAS f16*)(wsb + WS_QI); GAS f16* const KI = (GAS f16*)(wsb + WS_KI);
        GAS f16* const GLU = (GAS f16*)(wsb + WS_GLU); GAS f16* const GA = (GAS f16*)(wsb + WS_GA); GAS f16* const GC = (GAS f16*)(wsb + WS_GC); GAS float* const WI = (GAS float*)(wsb + WS_WI);
        const int row0 = u.pm * 256 + wr * 64 + fr;
        const int pn = u.pn;
        if (pn < 4) {
            const bool isq = pn < 2; const LAS float* g = gtab + (isq ? 0 : 64); GAS f16* O = isq ? Q : K;
            const int head = 4 * (pn & 1) + wc; const float sc = isq ? 0.125f * 1.4426950408889634f : 1.f;
            f32x4 gv[2][2];
#pragma unroll
            for (int bj = 0; bj < 2; ++bj)
#pragma unroll
                for (int n = 0; n < 2; ++n) gv[bj][n] = *(const LAS f32x4*)(g + 32 * bj + 8 * fq + 4 * n);
#pragma unroll
            for (int ai = 0; ai < 2; ++ai)
#pragma unroll
                for (int m = 0; m < 4; ++m) {
                    float ss = (sq4(acc[ai][0][m][0]) + sq4(acc[ai][0][m][1])) + (sq4(acc[ai][1][m][0]) + sq4(acc[ai][1][m][1]));
                    ss += __shfl_xor(ss, 16); ss += __shfl_xor(ss, 32);
                    const float rinv = __builtin_amdgcn_rsqf(ss * (1.f / 64.f) + EPS) * sc;
                    GAS f16* rowp = O + (size_t)(row0 + ai * 128 + m * 16) * 512 + head * 64 + 8 * fq;
#pragma unroll
                    for (int bj = 0; bj < 2; ++bj) *(GAS u32x4*)(rowp + 32 * bj) = pack8_bf16(acc[ai][bj][m][0] * rinv * gv[bj][0], acc[ai][bj][m][1] * rinv * gv[bj][1]);
                }
        } else if (pn < 8) {
            GAS f16* O = (pn < 6) ? V : QI; const float sc = (pn < 6) ? 1.f : 0.125f;
            const int col0 = 256 * (pn & 1) + 32 * wc + 8 * fq;
#pragma unroll
            for (int ai = 0; ai < 2; ++ai)
#pragma unroll
                for (int m = 0; m < 4; ++m) { GAS f16* rowp = O + (size_t)(row0 + ai * 128 + m * 16) * 512 + col0;
#pragma unroll
                    for (int bj = 0; bj < 2; ++bj) { if (pn < 6) *(GAS u32x4*)(rowp + 128 * bj) = pack8_bf16(acc[ai][bj][m][0], acc[ai][bj][m][1]); else *(GAS h8*)(rowp + 128 * bj) = pack8(acc[ai][bj][m][0] * sc, acc[ai][bj][m][1] * sc); } }
        } else if (pn == 8) {
#pragma unroll
            for (int ai = 0; ai < 2; ++ai)
#pragma unroll
                for (int m = 0; m < 4; ++m) { const size_t row = (size_t)(row0 + ai * 128 + m * 16);
                    if (wc < 2) *(GAS h8*)(KI + row * 64 + 32 * wc + 8 * fq) = pack8(acc[ai][0][m][0], acc[ai][0][m][1]);
                    else if (wc == 2 && fq == 0) { *(GAS f32x4*)(WI + row * 8) = acc[ai][0][m][0] * 0.35355339059f; *(GAS f32x4*)(WI + row * 8 + 4) = acc[ai][0][m][1] * 0.35355339059f; } }
        } else if (pn < 13) {
            const int col0 = 128 * (pn - 9) + 32 * wc + 8 * fq;
#pragma unroll
            for (int ai = 0; ai < 2; ++ai)
#pragma unroll
                for (int m = 0; m < 4; ++m)
                    *(GAS h8*)(GLU + (size_t)(row0 + ai * 128 + m * 16) * 512 + col0) = pack8(acc[ai][0][m][0] * sigm4(acc[ai][1][m][0]), acc[ai][0][m][1] * sigm4(acc[ai][1][m][1]));
        } else {
            GAS f16* O = (pn < 17) ? GA : GC; const int col0 = 256 * ((pn - 13) & 3) + 32 * wc + 8 * fq;
#pragma unroll
            for (int ai = 0; ai < 2; ++ai)
#pragma unroll
                for (int m = 0; m < 4; ++m) { GAS f16* rowp = O + (size_t)(row0 + ai * 128 + m * 16) * 1024 + col0;
#pragma unroll
                    for (int bj = 0; bj < 2; ++bj) *(GAS h8*)(rowp + 128 * bj) = pack8(sigm4(acc[ai][bj][m][0]), sigm4(acc[ai][bj][m][1])); }
        }
    }
};

__device__ __forceinline__ void h8_to_f(h8 v, f32x4& a, f32x4& b) {
    f32x8 f = __builtin_convertvector(v, f32x8);
    a = (f32x4){f[0], f[1], f[2], f[3]}; b = (f32x4){f[4], f[5], f[6], f[7]};
}

template <int MODE> struct EpiN {
    static constexpr bool PERM = true, AFTER_DRAIN = false;
    GAS f16* O16; const GAS f16* G16; const GAS float* RES; GAS float* OUT; GAS float* SSW; const GAS float* SSR; const GAS f16* R16;
    __device__ __forceinline__ void operator()(const f32x4 (&acc)[2][2][4][2], const pg8::Unit& u, int wr, int wc, int fr, int fq) const {
        const int row0 = u.pm * 256 + wr * 64 + fr, col0 = u.pn * 256 + 32 * wc + 8 * fq;
#pragma unroll
        for (int ai = 0; ai < 2; ++ai)
#pragma unroll
            for (int m = 0; m < 4; ++m) {
                const size_t row = (size_t)(row0 + ai * 128 + m * 16);
                float rstd = 1.f, ss = 0.f;
                if (MODE == 4) { const GAS f32x4* sp = (const GAS f32x4*)(SSR + row * 16); f32x4 s = (sp[0] + sp[1]) + (sp[2] + sp[3]);
                    rstd = __builtin_amdgcn_rsqf(((s[0] + s[1]) + (s[2] + s[3])) * (1.f / 1024.f) + EPS); }
#pragma unroll
                for (int bj = 0; bj < 2; ++bj) {
                    const size_t off = row * 1024 + col0 + 128 * bj;
                    const f32x4 a0 = acc[ai][bj][m][0], a1 = acc[ai][bj][m][1];
                    if (MODE == 0) { f32x4 g0, g1; h8_to_f(*(const GAS h8*)(G16 + off), g0, g1); *(GAS h8*)(O16 + off) = pack8(g0 * a0, g1 * a1); }
                    if (MODE == 1) { f32x4 g0, g1, p0, p1; h8_to_f(*(const GAS h8*)(G16 + off), g0, g1); h8_to_f(*(const GAS h8*)(O16 + off), p0, p1); *(GAS h8*)(O16 + off) = pack8(p0 + g0 * a0, p1 + g1 * a1); }
                    if (MODE == 2) { const f32x4 x0 = __builtin_nontemporal_load((const GAS f32x4*)(RES + off)) + a0, x1 = __builtin_nontemporal_load((const GAS f32x4*)(RES + off + 4)) + a1;
                        *(GAS h8*)(O16 + off) = pack8(x0, x1); ss += sq4(x0) + sq4(x1); }
                    if (MODE == 5) { f32x4 r0, r1; h8_to_f(*(const GAS h8*)(R16 + off), r0, r1); const f32x4 x0 = r0 + a0, x1 = r1 + a1;
                        *(GAS h8*)(O16 + off) = pack8(x0, x1); ss += sq4(x0) + sq4(x1); }
                    if (MODE == 3) { *(GAS h8*)(O16 + off) = pack8(a0, a1); }
                    if (MODE == 4) { f32x4 g0, g1; h8_to_f(*(const GAS h8*)(G16 + off), g0, g1);
                        f32x4 r0, r1; h8_to_f(*(const GAS h8*)(R16 + off), r0, r1);
                        const f32x4 x0 = r0 + sigm4(a0 * rstd) * g0, x1 = r1 + sigm4(a1 * rstd) * g1;
                        __builtin_nontemporal_store(x0, (GAS f32x4*)(OUT + off)); __builtin_nontemporal_store(x1, (GAS f32x4*)(OUT + off + 4)); }
                }
                if (MODE == 2 || MODE == 5) { ss += __shfl_xor(ss, 16); ss += __shfl_xor(ss, 32); if (fq == 0) SSW[row * 16 + u.pn * 4 + wc] = ss; }
                asm volatile("" ::: "memory");
            }
    }
};

struct EpiGU {
    static constexpr bool PERM = true, AFTER_DRAIN = false;
    GAS f16* ACT; const LAS float* tab; const LAS int* pml;
    __device__ __forceinline__ void operator()(const f32x4 (&acc)[2][2][4][2], const pg8::Unit& u, int wr, int wc, int fr, int fq) const {
        const int row0 = u.pm * 256 + wr * 64 + fr, col0 = u.pn * 128 + 32 * wc + 8 * fq;
        int slot = 0;
#pragma unroll
        for (int j = 1; j < 16; ++j) slot = (pml[j] == u.pm) ? j : slot;
        slot = (pml[0] == u.pm) ? 0 : slot;
        const LAS float* tb = tab + slot * 256 + wr * 64 + fr;
#pragma unroll
        for (int ai = 0; ai < 2; ++ai)
#pragma unroll
            for (int m = 0; m < 4; ++m) {
                const size_t row = (size_t)(row0 + ai * 128 + m * 16);
                const float rstd = tb[ai * 128 + m * 16];
                const f32x4 g0 = acc[ai][0][m][0] * rstd, g1 = acc[ai][0][m][1] * rstd, u0 = acc[ai][1][m][0] * rstd, u1 = acc[ai][1][m][1] * rstd;
                *(GAS h8*)(ACT + row * DFF + col0) = pack8(g0 * sigm4(g0) * u0, g1 * sigm4(g1) * u1);
                asm volatile("" ::: "memory");
            }
    }
};

__device__ __forceinline__ void tr_item(const GAS float* W, int ldn, int k0, int src0, GAS f16* WT, int K, int dst0, const GAS float* gk, LAS float* scr, int lane) {
    const GAS float* wp = W + (size_t)(k0 + (lane >> 5)) * ldn + src0 + (lane & 31);
    float v[32];
#pragma unroll
    for (int i = 0; i < 32; ++i) v[i] = __builtin_nontemporal_load(wp + (size_t)(2 * i) * ldn);
    const int c = lane & 7;
    f32x4 g0 = {1.f, 1.f, 1.f, 1.f}, g1 = {1.f, 1.f, 1.f, 1.f};
    if (gk) { g0 = *(const GAS f32x4*)(gk + k0 + 8 * c); g1 = *(const GAS f32x4*)(gk + k0 + 8 * c + 4); }
    __builtin_amdgcn_sched_barrier(0);
#pragma unroll
    for (int i = 0; i < 32; ++i) scr[(2 * i + (lane >> 5)) * 33 + (lane & 31)] = v[i];
    asm volatile("s_waitcnt lgkmcnt(0)" ::: "memory");
#pragma unroll
    for (int j = 0; j < 4; ++j) { const int n = (lane >> 3) + 8 * j; const LAS float* s = scr + (8 * c) * 33 + n;
        f32x8 o = {s[0] * g0[0], s[33] * g0[1], s[66] * g0[2], s[99] * g0[3], s[132] * g1[0], s[165] * g1[1], s[198] * g1[2], s[231] * g1[3]};
        *(GAS h8*)(WT + (size_t)(dst0 + n) * K + k0 + 8 * c) = __builtin_convertvector(o, h8); }
    asm volatile("s_waitcnt lgkmcnt(0)" ::: "memory");
}

template <int MODE> __device__ __forceinline__ void phase0(KP P, LAS unsigned char* lds, int gw, int NGW, int wave, int lane) {
    GAS unsigned char* ws = ((GAS unsigned char*)P->ws);
    LAS float* scr = (LAS float*)(lds + wave * 16384);
    constexpr int I1 = 16 * 168, I2 = 8 * 32, I4 = 16 * 32, I5 = 16 * 176, I6 = 44 * 32, I7 = 16 * 32, I8 = 4 * 32;
    constexpr int NIT = I1 + 2 * I2 + I4 + I5 + I6 + I7 + I8;
    if (MODE & 5) for (int it = ((MODE & 1) ? 0 : I1) + gw; it < ((MODE & 4) ? NIT : I1); it += NGW) {
        int r = it;
        if (r < I1) { const int kb = r / 168, grp = r % 168, pn = grp >> 3, g = grp & 7; int src0;
            if (pn < 4) src0 = ((pn < 2) ? 0 : 512) + 64 * (4 * (pn & 1) + (g & 3)) + 32 * (g >> 2);
            else if (pn < 8) src0 = 1024 + 256 * (pn - 4) + 32 * g;
            else if (pn == 8) src0 = (g < 2) ? 2048 + 32 * g : 2112;
            else if (pn < 13) src0 = (g < 4) ? 2120 + 128 * (pn - 9) + 32 * g : 2632 + 128 * (pn - 9) + 32 * (g - 4);
            else src0 = 3144 + 256 * (pn - 13) + 32 * g;
            tr_item(((const GAS float*)P->in[3]), INW, 64 * kb, src0, (GAS f16*)(ws + WS_W1T), 1024, 32 * grp, nullptr, scr, lane); continue; } r -= I1;
        if (r < I2) { tr_item(((const GAS float*)P->in[10]), 1024, 64 * (r / 32), 32 * (r % 32), (GAS f16*)(ws + WS_WAOT), 512, 32 * (r % 32), nullptr, scr, lane); continue; } r -= I2;
        if (r < I2) { tr_item(((const GAS float*)P->in[11]), 1024, 64 * (r / 32), 32 * (r % 32), (GAS f16*)(ws + WS_WCOT), 512, 32 * (r % 32), nullptr, scr, lane); continue; } r -= I2;
        if (r < I4) { tr_item(((const GAS float*)P->in[12]), 1024, 64 * (r / 32), 32 * (r % 32), (GAS f16*)(ws + WS_WOUTT), 1024, 32 * (r % 32), nullptr, scr, lane); continue; } r -= I4;
        if (r < I5) { const int kb = r / 176, grp = r % 176, j = grp >> 3, g = grp & 7;
            tr_item((g < 4) ? ((const GAS float*)P->in[14]) : ((const GAS float*)P->in[15]), DFF, 64 * kb, 128 * j + 32 * (g & 3), (GAS f16*)(ws + WS_WGUT), 1024, 32 * grp, ((const GAS float*)P->in[13]), scr, lane); continue; } r -= I5;
        if (r < I6) { tr_item(((const GAS float*)P->in[16]), 1024, 64 * (r / 32), 32 * (r % 32), (GAS f16*)(ws + WS_WDT), DFF, 32 * (r % 32), nullptr, scr, lane); continue; } r -= I6;
        if (r < I7) { tr_item(((const GAS float*)P->in[18]), 1024, 64 * (r / 32), 32 * (r % 32), (GAS f16*)(ws + WS_WPGT), 1024, 32 * (r % 32), ((const GAS float*)P->in[17]), scr, lane); continue; } r -= I7;
        tr_item(((const GAS float*)P->in[19]), 1024, 64 * (r / 32), 32 * (r % 32), (GAS f16*)(ws + WS_WPPT), 256, 32 * (r % 32), nullptr, scr, lane);
    }
    const GAS float* gm = ((const GAS float*)P->in[2]);
    f32x4 gv[4];
#pragma unroll
    for (int j = 0; j < 4; ++j) gv[j] = *((const GAS f32x4*)gm + lane + 64 * j);
    if (MODE & 2) for (int m0 = gw; m0 < TT; m0 += 2 * NGW) {
        const int m1 = (m0 + NGW < TT) ? m0 + NGW : m0;
        f32x4 v[2][4]; f32x4 pv[2]; float s[2] = {0.f, 0.f};
#pragma unroll
        for (int u = 0; u < 2; ++u) { const int m = u ? m1 : m0; const GAS f32x4* xr = (const GAS f32x4*)(((const GAS float*)P->in[0]) + (size_t)m * DM) + lane;
#pragma unroll
            for (int j = 0; j < 4; ++j) v[u][j] = __builtin_nontemporal_load(xr + 64 * j);
            pv[u] = __builtin_nontemporal_load((const GAS f32x4*)(((const GAS float*)P->in[1]) + (size_t)m * 256) + lane); }
#pragma unroll
        for (int u = 0; u < 2; ++u) {
            const int m = u ? m1 : m0;
#pragma unroll
            for (int j = 0; j < 4; ++j) s[u] += sq4(v[u][j]);
            const float rstd = __builtin_amdgcn_rsqf(wave_sum(s[u]) * (1.f / DM) + EPS);
            GAS f16* orow = (GAS f16*)(ws + WS_H) + (size_t)m * DM;
            typedef _Float16 h4 __attribute__((ext_vector_type(4)));
#pragma unroll
            for (int j = 0; j < 4; ++j) { f32x4 o = v[u][j] * rstd * gv[j]; *(GAS h4*)(orow + 4 * lane + 256 * j) = __builtin_convertvector(o, h4); }
            *(GAS h4*)((GAS f16*)(ws + WS_P16) + (size_t)m * 256 + 4 * lane) = __builtin_convertvector(pv[u], h4);
        }
    }
}

__device__ __forceinline__ void conv_phase(KP P, LAS unsigned char* lds, int gw, int NGW, int tid, int lane) {
    LAS float* cw = (LAS float*)lds;
    for (int i = tid; i < 31 * 512; i += 512) cw[i] = ((const GAS float*)P->in[6])[i];
    __syncthreads();
    const GAS f16* GLU = (const GAS f16*)(((GAS unsigned char*)P->ws) + WS_GLU); GAS f16* CONV = (GAS f16*)(((GAS unsigned char*)P->ws) + WS_CONV);
    const h8 zero8 = {0, 0, 0, 0, 0, 0, 0, 0};
    for (int ch = gw; ch < TT / 8; ch += NGW) {
        const int tok0 = 8 * ch, tl = tok0 & (SEQ - 1);
        float acc[8][8];
#pragma unroll
        for (int i = 0; i < 8; ++i)
#pragma unroll
            for (int c = 0; c < 8; ++c) acc[i][c] = 0.f;
        h8 buf[2][8];
#define CONV_LOAD(cc) do { _Pragma("unroll") for (int r = 0; r < 8; ++r) { const int rr = 8 * (cc) + r; if (rr < 38) { const int d = rr - 30; const bool ok = (tl + d >= 0); \
            const h8 x = *(const GAS h8*)(GLU + (size_t)(tok0 + (ok ? d : -tl)) * 512 + 8 * lane); buf[(cc) & 1][r] = ok ? x : zero8; } } } while (0)
        CONV_LOAD(0);
#pragma unroll
        for (int c = 0; c < 5; ++c) {
            __builtin_amdgcn_sched_barrier(0);
            if (c + 1 < 5) CONV_LOAD(c + 1);
            __builtin_amdgcn_sched_barrier(0);
#pragma unroll
            for (int r = 0; r < 8; ++r) {
                const int rr = 8 * c + r;
                if (rr < 38) {
                    const u32x4 xw = __builtin_bit_cast(u32x4, buf[c & 1][r]);
#pragma unroll
                    for (int i = 0; i < 8; ++i) {
                        const int j = rr - i;
                        if (j >= 0 && j <= 30) {
                            const f32x4 w0 = *(const LAS f32x4*)(cw + j * 512 + 8 * lane), w1 = *(const LAS f32x4*)(cw + j * 512 + 8 * lane + 4);
#pragma unroll
                            for (int e = 0; e < 4; ++e) { const float wl = (e < 2) ? w0[2 * e] : w1[2 * e - 4], wh = (e < 2) ? w0[2 * e + 1] : w1[2 * e - 3];
                                asm("v_fma_mix_f32 %0, %1, %2, %0 op_sel_hi:[0,1,0]" : "+v"(acc[i][2 * e]) : "v"(wl), "v"(xw[e]));
                                asm("v_fma_mix_f32 %0, %1, %2, %0 op_sel:[0,1,0] op_sel_hi:[0,1,0]" : "+v"(acc[i][2 * e + 1]) : "v"(wh), "v"(xw[e])); }
                        }
                    }
                }
            }
        }
#undef CONV_LOAD
        const f32x4 b0 = *(const GAS f32x4*)(((const GAS float*)P->in[7]) + 8 * lane), b1 = *(const GAS f32x4*)(((const GAS float*)P->in[7]) + 8 * lane + 4);
        const f32x4 g0 = *(const GAS f32x4*)(((const GAS float*)P->in[8]) + 8 * lane), g1 = *(const GAS f32x4*)(((const GAS float*)P->in[8]) + 8 * lane + 4);
        const f32x4 l0 = *(const GAS f32x4*)(((const GAS float*)P->in[9]) + 8 * lane), l1 = *(const GAS f32x4*)(((const GAS float*)P->in[9]) + 8 * lane + 4);
#pragma unroll
        for (int i = 0; i < 8; ++i) {
            f32x4 y0 = {acc[i][0], acc[i][1], acc[i][2], acc[i][3]}, y1 = {acc[i][4], acc[i][5], acc[i][6], acc[i][7]};
            y0 += b0; y1 += b1;
            const float mu = wave_sum((y0[0] + y0[1]) + (y0[2] + y0[3]) + (y1[0] + y1[1]) + (y1[2] + y1[3])) * (1.f / 512.f);
            y0 -= mu; y1 -= mu;
            const float rstd = __builtin_amdgcn_rsqf(wave_sum(sq4(y0) + sq4(y1)) * (1.f / 512.f) + EPS);
            y0 = y0 * rstd * g0 + l0; y1 = y1 * rstd * g1 + l1;
            *(GAS h8*)(CONV + (size_t)(tok0 + i) * 512 + 8 * lane) = pack8(y0 * sigm4(y0), y1 * sigm4(y1));
        }
    }
    __syncthreads();
}

__device__ __forceinline__ void find_bin(LAS unsigned* H, int lane, unsigned need, unsigned& bin, unsigned& rem) {
    const u32x4 h = *(const LAS u32x4*)(H + 4 * lane);
    const unsigned c4 = (h[0] + h[1]) + (h[2] + h[3]);
    unsigned S = c4;
#pragma unroll
    for (int o = 1; o < 64; o <<= 1) { const unsigned t = __shfl_down(S, o); if (lane + o < 64) S += t; }
    unsigned a = S - c4, fb = 0, fr = 0; bool found = false;
#pragma unroll
    for (int b = 3; b >= 0; --b) { const unsigned hb = h[b]; if (!found && a < need && a + hb >= need) { found = true; fb = 4 * lane + b; fr = need - a; } a += hb; }
    const unsigned long long mk = __ballot(found);
    const int src = mk ? (__ffsll((long long)mk) - 1) : 0;
    bin = __shfl(fb, src); rem = __shfl(fr, src);
}

template <int MODE> __device__ __forceinline__ void indexer_pair(LAS unsigned char* lds, const GAS f16* KI, int b, int t0, int ntiles, int tile, int n, int g,
        const h8 (&A)[2][4], const float (&w)[2][2][8], const h8 (&BA)[4], const h8 (&BB)[4], h8 (&NA)[4], h8 (&NB)[4]) {
    LAS unsigned short* KS = (LAS unsigned short*)lds;
        const bool hasB = tile + NW < ntiles;
        const int tna = (tile + 2 * NW < ntiles) ? tile + 2 * NW : tile, tnb = (tile + 3 * NW < ntiles) ? tile + 3 * NW : tna;
        const GAS h8* pa = (const GAS h8*)(KI + (size_t)(b * SEQ + tna * 32 + n) * 64 + 32 * g);
        const GAS h8* pb = (const GAS h8*)(KI + (size_t)(b * SEQ + tnb * 32 + n) * 64 + 32 * g);
        #pragma unroll
        for (int kk = 0; kk < 4; ++kk) { NA[kk] = pa[kk]; NB[kk] = pb[kk]; }
        f32x16 cA[2], cB[2];
#pragma unroll
        for (int mt = 0; mt < 2; ++mt) { cA[mt] = __builtin_amdgcn_mfma_f32_32x32x16_f16(A[mt][0], BA[0], f32x16{}, 0, 0, 0); cB[mt] = __builtin_amdgcn_mfma_f32_32x32x16_f16(A[mt][0], BB[0], f32x16{}, 0, 0, 0); }
#pragma unroll
        for (int kk = 1; kk < 4; ++kk)
#pragma unroll
            for (int mt = 0; mt < 2; ++mt) { cA[mt] = __builtin_amdgcn_mfma_f32_32x32x16_f16(A[mt][kk], BA[kk], cA[mt], 0, 0, 0); cB[mt] = __builtin_amdgcn_mfma_f32_32x32x16_f16(A[mt][kk], BB[kk], cB[mt], 0, 0, 0); }
#pragma unroll
        for (int u = 0; u < 2; ++u) {
            const int s = (tile + u * NW) * 32 + n;
            if (u == 0 || hasB) {
#pragma unroll
                for (int mt = 0; mt < 2; ++mt)
#pragma unroll
                    for (int qq = 0; qq < 2; ++qq) {
                        float sc = 0.f;
#pragma unroll
                        for (int h = 0; h < 8; ++h) sc += w[mt][qq][h] * fmaxf(u ? cB[mt][8 * qq + h] : cA[mt][8 * qq + h], 0.f);
                        const int ql = 4 * mt + 2 * g + qq;
                        int key = (int)(sc * 4096.f + 32768.5f);
                        key = key < 1 ? 1 : (key > 65535 ? 65535 : key);
                        if (s > t0 + ql) key = 0;
                        KS[ql * SEQ + s] = (unsigned short)key;
                        __hip_atomic_fetch_add((LAS unsigned*)(lds + 131072) + ql * 256 + (key >> 8), 1u, __ATOMIC_RELAXED, __HIP_MEMORY_SCOPE_WORKGROUP);
                    }
            }
        }
}

template <int MODE> __device__ __forceinline__ void indexer_item(KP P, LAS unsigned char* lds, int b, int t0, int wave, int lane) {
    LAS unsigned short* KS = (LAS unsigned short*)lds;
    const GAS f16* QI = (const GAS f16*)(((GAS unsigned char*)P->ws) + WS_QI); const GAS f16* KI = (const GAS f16*)(((GAS unsigned char*)P->ws) + WS_KI); const GAS float* WI = (const GAS float*)(((GAS unsigned char*)P->ws) + WS_WI);
    const int ntiles = (t0 + 8 + 31) >> 5, nkp = ntiles * 32;
    const int n = lane & 31, g = lane >> 5;
    h8 A[2][4]; float w[2][2][8];
#pragma unroll
    for (int mt = 0; mt < 2; ++mt) {
        const int ql = 2 * ((n >> 2) & 1) + (n >> 4), head = 4 * ((n >> 3) & 1) + (n & 3);
        const GAS h8* src = (const GAS h8*)(QI + (size_t)(b * SEQ + t0 + 4 * mt + ql) * 512 + head * 64 + 32 * g);
#pragma unroll
        for (int kk = 0; kk < 4; ++kk) A[mt][kk] = src[kk];
#pragma unroll
        for (int qq = 0; qq < 2; ++qq) { const GAS float* wp = WI + (size_t)(b * SEQ + t0 + 4 * mt + 2 * g + qq) * 8;
            const f32x4 wa = *(const GAS f32x4*)wp, wb = *(const GAS f32x4*)(wp + 4);
#pragma unroll
            for (int h = 0; h < 4; ++h) { w[mt][qq][h] = wa[h]; w[mt][qq][4 + h] = wb[h]; } }
    }
    h8 B0a[4], B0b[4], B1a[4], B1b[4];
    {   const int ta = (wave < ntiles) ? wave : 0, tb = (wave + NW < ntiles) ? wave + NW : ta;
        const GAS h8* pa = (const GAS h8*)(KI + (size_t)(b * SEQ + ta * 32 + n) * 64 + 32 * g);
        const GAS h8* pb = (const GAS h8*)(KI + (size_t)(b * SEQ + tb * 32 + n) * 64 + 32 * g);
#pragma unroll
        for (int kk = 0; kk < 4; ++kk) { B0a[kk] = pa[kk]; B0b[kk] = pb[kk]; } }
    for (int tile = wave; tile < ntiles; tile += 4 * NW) {
        indexer_pair<MODE>(lds, KI, b, t0, ntiles, tile, n, g, A, w, B0a, B0b, B1a, B1b);
        if (tile + 2 * NW < ntiles) indexer_pair<MODE>(lds, KI, b, t0, ntiles, tile + 2 * NW, n, g, A, w, B1a, B1b, B0a, B0b);
    }
    __syncthreads();
    if (MODE & 1) {
        const int t = t0 + wave;
        LAS unsigned short* row = KS + wave * SEQ;
        LAS unsigned* H = (LAS unsigned*)(lds + 131072 + wave * 1024);
        unsigned B1, r1; find_bin(H, lane, 256u, B1, r1);
        *(LAS u32x4*)(H + 4 * lane) = (u32x4){0u, 0u, 0u, 0u};
        for (int s8 = 8 * lane; s8 < nkp; s8 += 512) {
            const u32x4 v = *(const LAS u32x4*)(row + s8);
#pragma unroll
            for (int e = 0; e < 4; ++e) { const unsigned lo = v[e] & 0xffffu, hi = v[e] >> 16;
                if ((lo >> 8) == B1) __hip_atomic_fetch_add(H + (lo & 255u), 1u, __ATOMIC_RELAXED, __HIP_MEMORY_SCOPE_WORKGROUP);
                if ((hi >> 8) == B1) __hip_atomic_fetch_add(H + (hi & 255u), 1u, __ATOMIC_RELAXED, __HIP_MEMORY_SCOPE_WORKGROUP); }
        }
        asm volatile("s_waitcnt lgkmcnt(0)" ::: "memory");
        unsigned B2, r2; find_bin(H, lane, r1, B2, r2);
        *(LAS u32x4*)(H + 4 * lane) = (u32x4){0u, 0u, 0u, 0u};
        const unsigned T = (B1 << 8) | B2;
        LAS unsigned char* mimg = (LAS unsigned char*)(lds + 139264 + wave * 1024);
        *(LAS u32x4*)(mimg + 16 * lane) = (u32x4){0u, 0u, 0u, 0u};
        unsigned eqseen = 0;
        const unsigned long long ltmask = (1ull << lane) - 1ull;
        for (int sb = 0; sb < nkp; sb += 512) {
            const int s8 = sb + 8 * lane;
            u32x4 v = {0u, 0u, 0u, 0u};
            if (s8 < nkp) v = *(const LAS u32x4*)(row + s8);
            unsigned kk[8];
#pragma unroll
            for (int e = 0; e < 4; ++e) { kk[2 * e] = v[e] & 0xffffu; kk[2 * e + 1] = v[e] >> 16; }
            unsigned eqb = 0, gtb = 0;
#pragma unroll
            for (int e = 0; e < 8; ++e) { eqb |= (kk[e] == T) ? (1u << e) : 0u; gtb |= (kk[e] > T) ? (1u << e) : 0u; }
            unsigned takeeq = 0;
            if (__ballot(eqb != 0u)) {
                unsigned lower = 0, tot = 0;
#pragma unroll
                for (int e = 0; e < 8; ++e) { const unsigned long long m = __ballot((eqb >> e) & 1u); lower += (unsigned)__popcll(m & ltmask); tot += (unsigned)__popcll(m); }
#pragma unroll
                for (int e = 0; e < 8; ++e) { const unsigned rk = eqseen + lower + (unsigned)__builtin_popcount(eqb & ((1u << e) - 1u)); if (((eqb >> e) & 1u) && rk < r2) takeeq |= 1u << e; }
                eqseen += tot;
            }
            if (s8 < nkp) mimg[s8 >> 3] = (unsigned char)(gtb | takeeq);
        }
        asm volatile("s_waitcnt lgkmcnt(0)" ::: "memory");
        {   GAS unsigned long long* mo = (GAS unsigned long long*)(((GAS unsigned char*)P->ws) + WS_MASK) + (size_t)b * 128 * SEQ + t;
            const int ntq = 4 * ((t >> 8) + 1);
#pragma unroll
            for (int h2 = 0; h2 < 2; ++h2) { const int tile = lane + 64 * h2;
                if (tile < ntq) { const u32x4 dummy = {0u, 0u, 0u, 0u}; (void)dummy;
                    const unsigned lo = *(const LAS unsigned*)(mimg + 8 * tile), hi = *(const LAS unsigned*)(mimg + 8 * tile + 4);
                    mo[(size_t)tile * SEQ] = (unsigned long long)lo | ((unsigned long long)hi << 32); } }
        }
        asm volatile("s_waitcnt lgkmcnt(0)" ::: "memory");
    }
    __syncthreads();
}

__device__ __forceinline__ void causal_masks(KP P, int b, int t, int lane) {
    if (lane < 4) { const int rel = t - 64 * lane;
        const unsigned long long m = (rel >= 63) ? ~0ull : (rel < 0 ? 0ull : ((1ull << (rel + 1)) - 1ull));
        ((GAS unsigned long long*)(((GAS unsigned char*)P->ws) + WS_MASK))[((size_t)b * 128 + lane) * SEQ + t] = m; }
}
template <int MODE> __device__ __forceinline__ void indexer_phase(KP P, LAS unsigned char* lds, int G, int c, int wave, int lane) {
    *(LAS u32x4*)(lds + 131072 + (wave * 64 + lane) * 16) = (u32x4){0u, 0u, 0u, 0u};
    __syncthreads();
    if (G == 256) {
        for (int rr = 0; rr < 8; ++rr) { const int b = rr >> 2, q = rr & 3;
            const int blk = (q == 0) ? c : (q == 1) ? 511 - c : (q == 2) ? 512 + c : 1023 - c;
            if (8 * blk + 7 >= 256) indexer_item<MODE>(P, lds, b, 8 * blk, wave, lane); else causal_masks(P, b, 8 * blk + wave, lane); }
    } else {
        for (int it = c; it < 2048; it += G) { const int b = it >> 10, blk = it & 1023; if (8 * blk + 7 >= 256) indexer_item<MODE>(P, lds, b, 8 * blk, wave, lane); else causal_masks(P, b, 8 * blk + wave, lane); }
    }
}

__device__ __forceinline__ float dot8(h8 a, h8 b) {
    float r = __builtin_amdgcn_fdot2(__builtin_shufflevector(a, a, 0, 1), __builtin_shufflevector(b, b, 0, 1), 0.f, false);
    r = __builtin_amdgcn_fdot2(__builtin_shufflevector(a, a, 2, 3), __builtin_shufflevector(b, b, 2, 3), r, false);
    r = __builtin_amdgcn_fdot2(__builtin_shufflevector(a, a, 4, 5), __builtin_shufflevector(b, b, 4, 5), r, false);
    r = __builtin_amdgcn_fdot2(__builtin_shufflevector(a, a, 6, 7), __builtin_shufflevector(b, b, 6, 7), r, false);
    return r;
}
__device__ __forceinline__ void attn_phase(KP P, int gw, int NGW, int lane) {
    const GAS f16* Q = (const GAS f16*)(((GAS unsigned char*)P->ws) + WS_Q); const GAS f16* K = (const GAS f16*)(((GAS unsigned char*)P->ws) + WS_K); const GAS f16* V = (const GAS f16*)(((GAS unsigned char*)P->ws) + WS_V);
    GAS f16* ATT = (GAS f16*)(((GAS unsigned char*)P->ws) + WS_ATT); const GAS unsigned short* SEL = (const GAS unsigned short*)(((GAS unsigned char*)P->ws) + WS_SEL);
    const int kslot = lane >> 3, sub = lane & 7;
    for (int tok = gw; tok < TT; tok += NGW) {
        const int t = tok & (SEQ - 1), b = tok >> 13;
        const int nsel = (t + 1 < 256) ? t + 1 : 256; const bool implicit = t < 256;
        const int nit = (nsel + 7) >> 3;
        h8 q[8];
#pragma unroll
        for (int c = 0; c < 8; ++c) q[c] = *(const GAS h8*)(Q + (size_t)tok * 512 + 64 * c + 8 * sub);
        float den[8], acc[8][8];
#pragma unroll
        for (int c = 0; c < 8; ++c) { den[c] = 0.f;
#pragma unroll
            for (int d = 0; d < 8; ++d) acc[c][d] = 0.f; }
        const GAS unsigned short* selp = SEL + (size_t)tok * 256;
        for (int it = 0; it < nit; ++it) {
            const int j = 8 * it + kslot; const bool valid = j < nsel;
            int s = 0;
            if (valid) s = implicit ? j : (int)selp[j];
            const size_t ro = (size_t)(b * SEQ + s) * 512 + 8 * sub;
            h8 kv[8], vv[8];
#pragma unroll
            for (int c = 0; c < 8; ++c) kv[c] = *(const GAS h8*)(K + ro + 64 * c);
#pragma unroll
            for (int c = 0; c < 8; ++c) vv[c] = *(const GAS h8*)(V + ro + 64 * c);
#pragma unroll
            for (int c = 0; c < 8; ++c) {
                float pt = dot8(q[c], kv[c]);
                pt += __shfl_xor(pt, 1); pt += __shfl_xor(pt, 2); pt += __shfl_xor(pt, 4);
                const float p = valid ? __expf(pt) : 0.f;
                den[c] += p;
                const f32x8 vf = __builtin_convertvector(vv[c], f32x8);
#pragma unroll
                for (int d = 0; d < 8; ++d) acc[c][d] += p * vf[d];
            }
        }
#pragma unroll
        for (int c = 0; c < 8; ++c) {
            den[c] += __shfl_xor(den[c], 8); den[c] += __shfl_xor(den[c], 16); den[c] += __shfl_xor(den[c], 32);
#pragma unroll
            for (int d = 0; d < 8; ++d) { float a = acc[c][d]; a += __shfl_xor(a, 8); a += __shfl_xor(a, 16); a += __shfl_xor(a, 32); acc[c][d] = a; }
        }
#pragma unroll
        for (int c = 0; c < 8; ++c) if (kslot == c) {
            const float inv = 1.f / den[c];
            f32x8 o;
#pragma unroll
            for (int d = 0; d < 8; ++d) o[d] = acc[c][d] * inv;
            *(GAS h8*)(ATT + (size_t)tok * 512 + 64 * c + 8 * sub) = __builtin_convertvector(o, h8);
        }
    }
}


__device__ __forceinline__ float dpp_ror8(float x) { return __builtin_bit_cast(float, __builtin_amdgcn_update_dpp(0, __builtin_bit_cast(int, x), 0x128, 0xf, 0xf, false)); }
__device__ __forceinline__ void attn_phase2(KP P, int gw, int NGW, int lane) {
    const GAS f16* Q = (const GAS f16*)(((GAS unsigned char*)P->ws) + WS_Q); const GAS f16* K = (const GAS f16*)(((GAS unsigned char*)P->ws) + WS_K); const GAS f16* V = (const GAS f16*)(((GAS unsigned char*)P->ws) + WS_V);
    GAS f16* ATT = (GAS f16*)(((GAS unsigned char*)P->ws) + WS_ATT); const GAS unsigned short* SEL = (const GAS unsigned short*)(((GAS unsigned char*)P->ws) + WS_SEL);
    const int r = lane & 15, g = lane >> 4, hh = r & 7, half = r >> 3;
    const h8 zero8 = {0, 0, 0, 0, 0, 0, 0, 0};
    for (int tok = gw; tok < TT; tok += NGW) {
        const int t = tok & (SEQ - 1), b = tok >> 13;
        const int nsel = (t + 1 < 256) ? t + 1 : 256; const bool implicit = t < 256;
        const int nit = (nsel + 15) >> 4;
        h8 qf[2];
#pragma unroll
        for (int e = 0; e < 2; ++e) qf[e] = (r < 8) ? *(const GAS h8*)(Q + (size_t)tok * 512 + 64 * r + 32 * e + 8 * g) : zero8;
        const GAS unsigned short* selp = SEL + (size_t)tok * 256;
        const GAS f16* Kb = K + (size_t)b * SEQ * 512 + 8 * g; const GAS f16* Vb = V + (size_t)b * SEQ * 512 + 64 * hh + 32 * half;
        int sr, sv[4];
        if (implicit) { sr = (r < nsel) ? r : 0;
#pragma unroll
            for (int i = 0; i < 4; ++i) sv[i] = (4 * g + i < nsel) ? 4 * g + i : 0; }
        else { sr = selp[r]; const unsigned long long w = *(const GAS unsigned long long*)(selp + 4 * g);
#pragma unroll
            for (int i = 0; i < 4; ++i) sv[i] = (int)((w >> (16 * i)) & 0xffffu); }
        h8 kf[16], vf[4][4];
#pragma unroll
        for (int s = 0; s < 16; ++s) kf[s] = *(const GAS h8*)(Kb + (size_t)sr * 512 + 32 * s);
#pragma unroll
        for (int i = 0; i < 4; ++i)
#pragma unroll
            for (int c = 0; c < 4; ++c) vf[i][c] = *(const GAS h8*)(Vb + (size_t)sv[i] * 512 + 8 * c);
        float acc[32], den = 0.f;
#pragma unroll
        for (int d = 0; d < 32; ++d) acc[d] = 0.f;
        for (int it = 0; it < nit; ++it) {
            const bool more = it + 1 < nit;
            int srn = 0, svn[4] = {0, 0, 0, 0};
            if (more) {
                const int j0 = 16 * (it + 1);
                if (implicit) { srn = (j0 + r < nsel) ? j0 + r : 0;
#pragma unroll
                    for (int i = 0; i < 4; ++i) svn[i] = (j0 + 4 * g + i < nsel) ? j0 + 4 * g + i : 0; }
                else { srn = selp[j0 + r]; const unsigned long long w = *(const GAS unsigned long long*)(selp + j0 + 4 * g);
#pragma unroll
                    for (int i = 0; i < 4; ++i) svn[i] = (int)((w >> (16 * i)) & 0xffffu); }
            }
            f32x4 c = {0.f, 0.f, 0.f, 0.f};
            int rr = r; asm volatile("" : "+v"(rr));
#pragma unroll
            for (int s = 0; s < 16; ++s) { const h8 bq = (rr == (s >> 1)) ? qf[s & 1] : zero8; c = __builtin_amdgcn_mfma_f32_16x16x32_f16(kf[s], bq, c, 0, 0, 0); }
            if (more) {
#pragma unroll
                for (int s = 0; s < 16; ++s) kf[s] = *(const GAS h8*)(Kb + (size_t)srn * 512 + 32 * s);
            }
            float p[4];
#pragma unroll
            for (int i = 0; i < 4; ++i) { const int j = 16 * it + 4 * g + i; float pi = (j < nsel && r < 8) ? __expf(c[i]) : 0.f; den += pi; p[i] = pi + dpp_ror8(pi); }
#pragma unroll
            for (int i = 0; i < 4; ++i)
#pragma unroll
                for (int cc = 0; cc < 4; ++cc)
#pragma unroll
                    for (int e = 0; e < 4; ++e) { const unsigned vw = __builtin_bit_cast(u32x4, vf[i][cc])[e];
                        asm("v_fma_mix_f32 %0, %1, %2, %0 op_sel_hi:[0,1,0]" : "+v"(acc[8 * cc + 2 * e]) : "v"(p[i]), "v"(vw));
                        asm("v_fma_mix_f32 %0, %1, %2, %0 op_sel:[0,1,0] op_sel_hi:[0,1,0]" : "+v"(acc[8 * cc + 2 * e + 1]) : "v"(p[i]), "v"(vw)); }
            if (more) {
#pragma unroll
                for (int i = 0; i < 4; ++i)
#pragma unroll
                    for (int cc = 0; cc < 4; ++cc) vf[i][cc] = *(const GAS h8*)(Vb + (size_t)svn[i] * 512 + 8 * cc);
            }
        }
        den += dpp_ror8(den);
        den += __shfl_xor(den, 16); den += __shfl_xor(den, 32);
        const float inv = 1.f / den;
#pragma unroll
        for (int d = 0; d < 32; ++d) { float a = acc[d]; a += __shfl_xor(a, 16); a += __shfl_xor(a, 32); acc[d] = a * inv; }
#pragma unroll
        for (int cc = 0; cc < 4; ++cc) if (g == cc) {
            f32x8 o;
#pragma unroll
            for (int e = 0; e < 8; ++e) o[e] = acc[8 * cc + e];
            *(GAS h8*)(ATT + (size_t)tok * 512 + 64 * hh + 32 * half + 8 * cc) = __builtin_convertvector(o, h8);
        }
    }
}


template <int L> __device__ __forceinline__ float bcast_row(float x) { return __builtin_bit_cast(float, __builtin_amdgcn_update_dpp(0, __builtin_bit_cast(int, x), 0x150 + L, 0xf, 0xf, false)); }
#define PV_STEP(i, cc) do { const float pa = bcast_row<2 * (cc)>(p[i]), pb = bcast_row<2 * (cc) + 1>(p[i]); const float pp = hi ? pb : pa; \
    _Pragma("unroll") for (int e = 0; e < 4; ++e) { const unsigned vw = __builtin_bit_cast(u32x4, vf[i][cc])[e]; \
        asm("v_fma_mix_f32 %0, %1, %2, %0 op_sel_hi:[0,1,0]" : "+v"(acc[8 * (cc) + 2 * e]) : "v"(pp), "v"(vw)); \
        asm("v_fma_mix_f32 %0, %1, %2, %0 op_sel:[0,1,0] op_sel_hi:[0,1,0]" : "+v"(acc[8 * (cc) + 2 * e + 1]) : "v"(pp), "v"(vw)); } } while (0)
__device__ __forceinline__ void attn_phase3(KP P, LAS unsigned char* lds, int gw, int NGW, int wave, int lane) {
    const GAS f16* Q = (const GAS f16*)(((GAS unsigned char*)P->ws) + WS_Q); const GAS f16* K = (const GAS f16*)(((GAS unsigned char*)P->ws) + WS_K); const GAS f16* V = (const GAS f16*)(((GAS unsigned char*)P->ws) + WS_V);
    GAS f16* ATT = (GAS f16*)(((GAS unsigned char*)P->ws) + WS_ATT); const GAS unsigned short* SEL = (const GAS unsigned short*)(((GAS unsigned char*)P->ws) + WS_SEL);
    const int r = lane & 15, g = lane >> 4; const bool hi = (r >> 3) != 0;
    const h8 zero8 = {0, 0, 0, 0, 0, 0, 0, 0};
    LAS unsigned short* sidx = (LAS unsigned short*)(lds + wave * 512);
    for (int tok = gw; tok < TT; tok += NGW) {
        const int t = tok & (SEQ - 1), b = tok >> 13;
        const int nsel = (t + 1 < 256) ? t + 1 : 256; const bool implicit = t < 256;
        const int nit = (nsel + 15) >> 4;
        const GAS unsigned short* selp = SEL + (size_t)tok * 256;
        {   unsigned long long w;
            if (implicit) { w = 0ull;
#pragma unroll
                for (int k = 0; k < 4; ++k) { const int j = 4 * lane + k; w |= (unsigned long long)((j < nsel) ? j : 0) << (16 * k); } }
            else w = *(const GAS unsigned long long*)(selp + 4 * lane);
            *(LAS unsigned long long*)(sidx + 4 * lane) = w; }
        h8 qf[2];
#pragma unroll
        for (int e = 0; e < 2; ++e) qf[e] = (r < 8) ? *(const GAS h8*)(Q + (size_t)tok * 512 + 64 * r + 32 * e + 8 * g) : zero8;
        const GAS f16* Kb = K + (size_t)b * SEQ * 512 + 8 * g; const GAS f16* Vb = V + (size_t)b * SEQ * 512 + 8 * r;
        int sr = sidx[r]; unsigned long long sw = *(const LAS unsigned long long*)(sidx + 4 * g);
        h8 kf[16], vf[4][4];
#pragma unroll
        for (int s = 0; s < 16; ++s) kf[s] = *(const GAS h8*)(Kb + (size_t)sr * 512 + 32 * s);
#pragma unroll
        for (int i = 0; i < 4; ++i) { const int sv = (int)((sw >> (16 * i)) & 0xffffu);
#pragma unroll
            for (int c = 0; c < 4; ++c) vf[i][c] = *(const GAS h8*)(Vb + (size_t)sv * 512 + 128 * c); }
        float acc[32], den = 0.f;
#pragma unroll
        for (int d = 0; d < 32; ++d) acc[d] = 0.f;
        for (int it = 0; it < nit; ++it) {
            const int itn = (it + 1 < nit) ? it + 1 : 0;
            sr = sidx[16 * itn + r]; sw = *(const LAS unsigned long long*)(sidx + 16 * itn + 4 * g);
            f32x4 c = {0.f, 0.f, 0.f, 0.f};
            int rr = r; asm volatile("" : "+v"(rr));
#pragma unroll
            for (int s = 0; s < 16; ++s) { const h8 bq = (rr == (s >> 1)) ? qf[s & 1] : zero8; c = __builtin_amdgcn_mfma_f32_16x16x32_f16(kf[s], bq, c, 0, 0, 0); }
            __builtin_amdgcn_sched_barrier(0);
#pragma unroll
            for (int s = 0; s < 16; ++s) kf[s] = *(const GAS h8*)(Kb + (size_t)sr * 512 + 32 * s);
            __builtin_amdgcn_sched_barrier(0);
            float p[4];
#pragma unroll
            for (int i = 0; i < 4; ++i) { const int j = 16 * it + 4 * g + i; p[i] = (j < nsel && r < 8) ? __expf(c[i]) : 0.f; den += p[i]; }
#pragma unroll
            for (int i = 0; i < 4; ++i) { PV_STEP(i, 0); PV_STEP(i, 1); PV_STEP(i, 2); PV_STEP(i, 3); }
            __builtin_amdgcn_sched_barrier(0);
#pragma unroll
            for (int i = 0; i < 4; ++i) { const int sv = (int)((sw >> (16 * i)) & 0xffffu);
#pragma unroll
                for (int cc = 0; cc < 4; ++cc) vf[i][cc] = *(const GAS h8*)(Vb + (size_t)sv * 512 + 128 * cc); }
        }
        den += __shfl_xor(den, 16); den += __shfl_xor(den, 32);
        float dinv[4];
        { const float d0 = bcast_row<0>(den), d1 = bcast_row<1>(den), d2 = bcast_row<2>(den), d3 = bcast_row<3>(den), d4 = bcast_row<4>(den), d5 = bcast_row<5>(den), d6 = bcast_row<6>(den), d7 = bcast_row<7>(den);
          dinv[0] = 1.f / (hi ? d1 : d0); dinv[1] = 1.f / (hi ? d3 : d2); dinv[2] = 1.f / (hi ? d5 : d4); dinv[3] = 1.f / (hi ? d7 : d6); }
#pragma unroll
        for (int d = 0; d < 32; ++d) { float a = acc[d]; a += __shfl_xor(a, 16); a += __shfl_xor(a, 32); acc[d] = a * dinv[d >> 3]; }
#pragma unroll
        for (int cc = 0; cc < 4; ++cc) if (g == cc) {
            f32x8 o;
#pragma unroll
            for (int e = 0; e < 8; ++e) o[e] = acc[8 * cc + e];
            *(GAS h8*)(ATT + (size_t)tok * 512 + 128 * cc + 8 * r) = __builtin_convertvector(o, h8);
        }
    }
}


template <int CTRL> __device__ __forceinline__ float dpp_add(float x) { return x + __builtin_bit_cast(float, __builtin_amdgcn_update_dpp(0, __builtin_bit_cast(int, x), CTRL, 0xf, 0xf, false)); }
__device__ __forceinline__ void attn_phase4(KP P, LAS unsigned char* lds, int gw, int NGW, int wave, int lane) {
    const GAS f16* Q = (const GAS f16*)(((GAS unsigned char*)P->ws) + WS_Q); const GAS f16* K = (const GAS f16*)(((GAS unsigned char*)P->ws) + WS_K); const GAS f16* V = (const GAS f16*)(((GAS unsigned char*)P->ws) + WS_V);
    GAS f16* ATT = (GAS f16*)(((GAS unsigned char*)P->ws) + WS_ATT); const GAS unsigned short* SEL = (const GAS unsigned short*)(((GAS unsigned char*)P->ws) + WS_SEL);
    const int kslot = lane >> 3, sub = lane & 7;
    LAS unsigned short* sidx = (LAS unsigned short*)(lds + wave * 512);
    for (int tok = gw; tok < TT; tok += NGW) {
        const int t = tok & (SEQ - 1), b = tok >> 13;
        const int nsel = (t + 1 < 256) ? t + 1 : 256; const bool implicit = t < 256;
        const int nit = (nsel + 7) >> 3;
        const GAS unsigned short* selp = SEL + (size_t)tok * 256;
        {   unsigned long long w;
            if (implicit) { w = 0ull;
#pragma unroll
                for (int k = 0; k < 4; ++k) { const int j = 4 * lane + k; w |= (unsigned long long)((j < nsel) ? j : 0) << (16 * k); } }
            else w = *(const GAS unsigned long long*)(selp + 4 * lane);
            asm volatile("" ::: "memory");
#pragma unroll
            for (int k = 0; k < 4; ++k) sidx[4 * lane + k] = (unsigned short)((w >> (16 * k)) & 0xffffull);
            asm volatile("s_waitcnt lgkmcnt(0)" ::: "memory"); }
        h8 q[8];
#pragma unroll
        for (int c = 0; c < 8; ++c) q[c] = *(const GAS h8*)(Q + (size_t)tok * 512 + 64 * c + 8 * sub);
        float den[8], acc[8][8];
#pragma unroll
        for (int c = 0; c < 8; ++c) { den[c] = 0.f;
#pragma unroll
            for (int d = 0; d < 8; ++d) acc[c][d] = 0.f; }
        const GAS f16* Kb = K + (size_t)b * SEQ * 512 + 8 * sub; const GAS f16* Vb = V + (size_t)b * SEQ * 512 + 8 * sub;
        int s = sidx[kslot];
        h8 kv[8], vv[8];
#pragma unroll
        for (int c = 0; c < 8; ++c) kv[c] = *(const GAS h8*)(Kb + (size_t)s * 512 + 64 * c);
#pragma unroll
        for (int c = 0; c < 8; ++c) vv[c] = *(const GAS h8*)(Vb + (size_t)s * 512 + 64 * c);
        for (int it = 0; it < nit; ++it) {
            const int itn = (it + 1 < nit) ? it + 1 : 0;
            s = sidx[8 * itn + kslot];
            const bool valid = (8 * it + kslot) < nsel;
            float p[8];
#pragma unroll
            for (int c = 0; c < 8; ++c) { float pt = dot8(q[c], kv[c]); pt = dpp_add<0xB1>(pt); pt = dpp_add<0x4E>(pt); pt = dpp_add<0x141>(pt); p[c] = pt; }
            __builtin_amdgcn_sched_barrier(0);
#pragma unroll
            for (int c = 0; c < 8; ++c) kv[c] = *(const GAS h8*)(Kb + (size_t)s * 512 + 64 * c);
            __builtin_amdgcn_sched_barrier(0);
#pragma unroll
            for (int c = 0; c < 8; ++c) {
                const float pe = valid ? __expf(p[c]) : 0.f;
                den[c] += pe;
#pragma unroll
                for (int e = 0; e < 4; ++e) { const unsigned vw = __builtin_bit_cast(u32x4, vv[c])[e];
                    asm("v_fma_mix_f32 %0, %1, %2, %0 op_sel_hi:[0,1,0]" : "+v"(acc[c][2 * e]) : "v"(pe), "v"(vw));
                    asm("v_fma_mix_f32 %0, %1, %2, %0 op_sel:[0,1,0] op_sel_hi:[0,1,0]" : "+v"(acc[c][2 * e + 1]) : "v"(pe), "v"(vw)); }
            }
            __builtin_amdgcn_sched_barrier(0);
#pragma unroll
            for (int c = 0; c < 8; ++c) vv[c] = *(const GAS h8*)(Vb + (size_t)s * 512 + 64 * c);
        }
#pragma unroll
        for (int c = 0; c < 8; ++c) {
            den[c] += __shfl_xor(den[c], 8); den[c] += __shfl_xor(den[c], 16); den[c] += __shfl_xor(den[c], 32);
#pragma unroll
            for (int d = 0; d < 8; ++d) { float a = acc[c][d]; a += __shfl_xor(a, 8); a += __shfl_xor(a, 16); a += __shfl_xor(a, 32); acc[c][d] = a; }
        }
#pragma unroll
        for (int c = 0; c < 8; ++c) if (kslot == c) {
            const float inv = 1.f / den[c];
            f32x8 o;
#pragma unroll
            for (int d = 0; d < 8; ++d) o[d] = acc[c][d] * inv;
            *(GAS h8*)(ATT + (size_t)tok * 512 + 64 * c + 8 * sub) = __builtin_convertvector(o, h8);
        }
    }
}

#define XB_TMO      128
#define XB_XCNT(j)  (256  + 64 * (j))
#define XB_XSUB(j)  (1280 + 64 * (j))
#define XB_XGEN(j)  (2304 + 64 * (j))
#define XB_TOP      3328
#define XB_TOPGEN   3392
#define XCD_BAR_WORDS 3456
#define XB_SPIN_CAP (1u << 18)

__device__ __forceinline__ unsigned xb_ld(unsigned* p)              { return __hip_atomic_load(p, __ATOMIC_RELAXED, __HIP_MEMORY_SCOPE_AGENT); }
__device__ __forceinline__ unsigned xb_add(unsigned* p, unsigned v) { return __hip_atomic_fetch_add(p, v, __ATOMIC_RELAXED, __HIP_MEMORY_SCOPE_AGENT); }
__device__ __forceinline__ unsigned xb_xcc_id() { return (unsigned)__builtin_amdgcn_s_getreg((3 << 11) | 20) & 0xFu; }
#define XB_SPIN(cond, bar) do { unsigned _sp = 0; while (cond) { __builtin_amdgcn_s_sleep(1); \
    if ((++_sp & 255u) == 0u) { if (xb_ld(&(bar)[XB_TMO])) break; if (_sp > XB_SPIN_CAP) { atomicAdd(&(bar)[XB_TMO], 1u); break; } } } } while (0)

struct XcdBarrier {
    unsigned* bar; unsigned x;
    volatile LAS unsigned* st;
};

__device__ __forceinline__ XcdBarrier xcd_barrier_post(unsigned* bar, volatile LAS unsigned* st) {
    XcdBarrier b; b.bar = bar; b.x = xb_xcc_id(); b.st = st;
    if (threadIdx.x == 0) (void)xb_add(&bar[XB_XCNT(b.x)], 1u);
    return b;
}
__device__ __forceinline__ void xcd_barrier_complete(unsigned* bar, unsigned x, unsigned& nloc, unsigned& nx) {
    const unsigned G = gridDim.x * gridDim.y * gridDim.z;
    unsigned sum, cnt, mine, sp = 0u;
    for (;;) {
        sum = 0u; cnt = 0u; mine = 0u;
#pragma unroll
        for (unsigned j = 0; j < 16; ++j) { const unsigned c = xb_ld(&bar[XB_XCNT(j)]); sum += c; cnt += (c > 0u) ? 1u : 0u; mine = (j == x) ? c : mine; }
        if (sum == G) break;
        __builtin_amdgcn_s_sleep(1);
        if ((++sp & 255u) == 0u) { if (xb_ld(&bar[XB_TMO])) break; if (sp > XB_SPIN_CAP) { atomicAdd(&bar[XB_TMO], 1u); break; } }
    }
    nloc = mine > 0u ? mine : 1u; nx = cnt > 0u ? cnt : 1u;
}

__device__ __forceinline__ void xcd_barrier(const XcdBarrier& b) {
    asm volatile("s_waitcnt vmcnt(0)" ::: "memory");
    __syncthreads();
    if (threadIdx.x == 0) {
        unsigned* bar = b.bar;
        __builtin_amdgcn_s_waitcnt(0);
        unsigned nloc = b.st[0], nx = b.st[1];
        if (nloc == 0u) { xcd_barrier_complete(bar, b.x, nloc, nx); b.st[0] = nloc; b.st[1] = nx; }
        const unsigned old = xb_add(&bar[XB_XSUB(b.x)], 1u);
        const unsigned gen = old / nloc;
        if (old + 1u == (gen + 1u) * nloc) {
            __builtin_amdgcn_fence(__ATOMIC_RELEASE, "agent");
            asm volatile("s_waitcnt vmcnt(0)" ::: "memory");
            const unsigned og = xb_add(&bar[XB_TOP], 1u);
            const unsigned tg = og / nx;
            if (og + 1u == (tg + 1u) * nx) xb_add(&bar[XB_TOPGEN], 1u);
            else XB_SPIN(xb_ld(&bar[XB_TOPGEN]) == tg, bar);
            __builtin_amdgcn_fence(__ATOMIC_ACQUIRE, "agent");
            xb_add(&bar[XB_XGEN(b.x)], 1u);
            asm volatile("s_waitcnt vmcnt(0)" ::: "memory");
        } else {
            XB_SPIN(xb_ld(&bar[XB_XGEN(b.x)]) == gen, bar);
            __builtin_amdgcn_fence(__ATOMIC_ACQUIRE, "agent");
            asm volatile("s_waitcnt vmcnt(0)" ::: "memory");
        }
    }
    __syncthreads();
}


#define GEMM_PHASE(EPI, epi, Aoff, Boff, NN, KK) do { int kk_ = (KK); asm volatile("" : "+s"(kk_)); pg8::Gemm g{(const pg8::bf16_t*)(ws + (Aoff)), (const pg8::bf16_t*)(ws + (Boff)), TT, (NN), kk_}; \
    pg8::StaticOrder S; S.init(TT, (NN), G, (int)blockIdx.x); pg8::gemm_phase<EPI, pg8::StaticOrder, true, true>(lds, g, S, epi, wave); } while (0)

__device__ __forceinline__ KP opaque_params() { KP p = (KP)__builtin_amdgcn_kernarg_segment_ptr(); asm volatile("" : "+s"(p)); return p; }
__global__ void __launch_bounds__(512) mega_fwd(Params P_) {
    extern __shared__ __attribute__((aligned(16))) unsigned char lds_raw[];
    LAS unsigned char* lds = (LAS unsigned char*)lds_raw;
    cg::grid_group grid = cg::this_grid();
    if (threadIdx.x < 16) ((LAS unsigned*)(lds + LDS_BYTES - 64))[threadIdx.x] = 0u;
    __syncthreads();
    const XcdBarrier xbar = xcd_barrier_post((unsigned*)(P_.ws + 65536), (volatile LAS unsigned*)(lds + LDS_BYTES - 64));
    const int wave = __builtin_amdgcn_readfirstlane(threadIdx.x >> 6);
    const int G = gridDim.x, bx = blockIdx.x;
    const int gw = bx * NW + wave, NGW = G * NW;
    GAS unsigned char* ws = (GAS unsigned char*)P_.ws;
#define LANEID(l) int l; asm volatile("v_mbcnt_lo_u32_b32 %0, -1, 0\n\tv_mbcnt_hi_u32_b32 %0, -1, %0" : "=v"(l))
#define PP (opaque_params())
    GAS f16* const GAp = (GAS f16*)(ws + WS_GA); GAS f16* const GCp = (GAS f16*)(ws + WS_GC);
    GAS float* const SS1 = (GAS float*)(ws + WS_SS1); GAS float* const SS2 = (GAS float*)(ws + WS_SS2);

    { LANEID(lane); phase0<7>(PP, lds, gw, NGW, wave, lane); }
    if (gridDim.x == 0x7fffffffu) grid.sync();
    xcd_barrier(xbar);
    {   LAS float* gtab = (LAS float*)(lds + 131072);
        if (threadIdx.x < 128) gtab[threadIdx.x] = (threadIdx.x < 64) ? ((const GAS float*)PP->in[4])[threadIdx.x] : ((const GAS float*)PP->in[5])[threadIdx.x - 64];
        __syncthreads();
        EpiG1 E{ws, gtab}; GEMM_PHASE(EpiG1, E, WS_H, WS_W1T, N1, 1024); }
    xcd_barrier(xbar);
    { LANEID(lane); conv_phase(PP, lds, gw, NGW, wave * 64 + lane, lane); }
    { LANEID(lane); indexer_phase<1>(PP, lds, G, bx, wave, lane); }
    xcd_barrier(xbar);
    { const attn_body::AttnTensors AT{(const attn_body::bf16*)(P_.ws + WS_Q), (const attn_body::bf16*)(P_.ws + WS_K), (const attn_body::bf16*)(P_.ws + WS_V), (attn_body::bf16*)(P_.ws + WS_ATT), (const unsigned long long*)(P_.ws + WS_MASK)};
      const attn_body::StaticOrder S(G, bx);
      bool safe;
      {   LANEID(lane); float gq = __builtin_fabsf(((const GAS float*)PP->in[4])[lane]), gk = __builtin_fabsf(((const GAS float*)PP->in[5])[lane]);
#pragma unroll
          for (int o = 1; o < 64; o <<= 1) { gq = fmaxf(gq, __shfl_xor(gq, o)); gk = fmaxf(gk, __shfl_xor(gk, o)); }
          safe = __builtin_amdgcn_readfirstlane((11.6f * gq * gk < 60.f) ? 1 : 0) != 0; }
      attn_body::attn_phase<attn_body::StaticOrder>((char*)lds_raw, AT, S, safe); }
    xcd_barrier(xbar);
    { EpiN<0> E{(GAS f16*)(ws + WS_MERGED), GAp, nullptr, nullptr, nullptr, nullptr, nullptr}; GEMM_PHASE(EpiN<0>, E, WS_ATT, WS_WAOT, 1024, 512); }
    { EpiN<1> E{(GAS f16*)(ws + WS_MERGED), GCp, nullptr, nullptr, nullptr, nullptr, nullptr}; GEMM_PHASE(EpiN<1>, E, WS_CONV, WS_WCOT, 1024, 512); }
    xcd_barrier(xbar);
    { EpiN<2> E{(GAS f16*)(ws + WS_X1H), nullptr, ((const GAS float*)PP->in[0]), nullptr, SS1, nullptr, nullptr}; GEMM_PHASE(EpiN<2>, E, WS_MERGED, WS_WOUTT, 1024, 1024); }
    xcd_barrier(xbar);
    {   LAS float* tab = (LAS float*)(lds + 131072); LAS int* pml = (LAS int*)(lds + 131072 + 16384);
        {   pg8::StaticOrder S0; S0.init(TT, NGU, G, (int)blockIdx.x); pg8::Unit u0; LANEID(lane);
            const int t = wave * 64 + lane;
            for (int i = 0; i < 16; ++i) {
                const bool ok = S0.next(i, u0);
                if (t == 0) pml[i] = ok ? u0.pm : -1;
                if (ok && t < 256) { const GAS f32x4* sp = (const GAS f32x4*)(SS1 + (size_t)(u0.pm * 256 + t) * 16); const f32x4 s = (sp[0] + sp[1]) + (sp[2] + sp[3]);
                    tab[i * 256 + t] = __builtin_amdgcn_rsqf(((s[0] + s[1]) + (s[2] + s[3])) * (1.f / 1024.f) + EPS); }
            }
            __syncthreads(); }
        EpiGU E{(GAS f16*)(ws + WS_ACT), tab, pml}; GEMM_PHASE(EpiGU, E, WS_X1H, WS_WGUT, NGU, 1024); }
    if (G == 256 && bx >= 128) {
        EpiN<3> E{(GAS f16*)(ws + WS_TMP), nullptr, nullptr, nullptr, nullptr, nullptr, nullptr};
        int kk_ = 256; asm volatile("" : "+s"(kk_));
        pg8::Gemm g{(const pg8::bf16_t*)(ws + WS_P16), (const pg8::bf16_t*)(ws + WS_WPPT), TT, 1024, kk_};
        pg8::StaticOrder S; S.init(TT, 1024, 128, (int)blockIdx.x - 128);
        pg8::gemm_phase<EpiN<3>, pg8::StaticOrder, true, true>(lds, g, S, E, wave);
    }
    xcd_barrier(xbar);
    { EpiN<5> E{(GAS f16*)(ws + WS_X2H), nullptr, nullptr, nullptr, SS2, nullptr, (const GAS f16*)(ws + WS_X1H)}; GEMM_PHASE(EpiN<5>, E, WS_ACT, WS_WDT, 1024, DFF); }
    xcd_barrier(xbar);
    if (G != 256) { EpiN<3> E{(GAS f16*)(ws + WS_TMP), nullptr, nullptr, nullptr, nullptr, nullptr, nullptr}; GEMM_PHASE(EpiN<3>, E, WS_P16, WS_WPPT, 1024, 256); }
    { EpiN<4> E{nullptr, (const GAS f16*)(ws + WS_TMP), nullptr, ((GAS float*)PP->out), nullptr, SS2, (const GAS f16*)(ws + WS_X2H)}; GEMM_PHASE(EpiN<4>, E, WS_X2H, WS_WPGT, 1024, 1024); }
}

extern "C" void kernel_launch(void* const* d_in, const int* in_sizes, int n_in, void* d_out, int out_size, void* d_ws, size_t ws_size, hipStream_t stream) {
    static int grid = 0;
    if (grid == 0) {
        if (n_in != 20 || out_size != TT * DM || ws_size < WS_END) { fprintf(stderr, "kernel_launch: unexpected problem shape (n_in %d out %d ws %zu)\n", n_in, out_size, ws_size); grid = -1; return; }
        int dev = 0, cus = 0, per_cu = 0;
        hipGetDevice(&dev); hipDeviceGetAttribute(&cus, hipDeviceAttributeMultiprocessorCount, dev);
        if (hipFuncSetAttribute((const void*)mega_fwd, hipFuncAttributeMaxDynamicSharedMemorySize, LDS_BYTES) != hipSuccess) { fprintf(stderr, "kernel_launch: hipFuncSetAttribute failed\n"); grid = -1; return; }
        if (hipOccupancyMaxActiveBlocksPerMultiprocessor(&per_cu, (const void*)mega_fwd, 512, LDS_BYTES) != hipSuccess || per_cu < 1) { fprintf(stderr, "kernel_launch: occupancy query says %d\n", per_cu); per_cu = 1; }
        (void)hipGetLastError();
        grid = cus;
    }
    if (grid < 0) return;
    if (hipMemsetAsync(d_ws, 0, 1u << 20, stream) != hipSuccess) { fprintf(stderr, "kernel_launch: memset failed\n"); return; }
    Params p{};
    for (int i = 0; i < 20; ++i) p.in[i] = (const float*)d_in[i];
    p.out = (float*)d_out; p.ws = (unsigned char*)d_ws;
    void* args[] = {&p};
    hipError_t e = hipLaunchCooperativeKernel((const void*)mega_fwd, dim3(grid), dim3(512), args, LDS_BYTES, stream);
    if (e != hipSuccess) fprintf(stderr, "cooperative launch failed: %s (grid %d)\n", hipGetErrorString(e), grid);
}
```
